# Optimizing an MI355X kernel written in HIP

```python
import math
import jax, jax.numpy as jnp
from jax import lax
import numpy as np

D_MODEL = 1024
BATCH = 8
SEQ = 2048
DEPTH = 2
DEC_BATCH = 128
DEC_SEQ = 8
PAST_LEN = 16384
PAGE_SIZE = 128

EPS = 1e-6
N_EVEN = (DEPTH + 1) // 2
N_ODD = DEPTH // 2
D_POOL = D_MODEL // 2
POOL_WINDOWS = (2, 4, 8, 16)
POOL_GROUPS = len(POOL_WINDOWS)
POOL_GC = D_POOL // POOL_GROUPS
POOL_PREV = max(POOL_WINDOWS) - 1
D_CONV = D_MODEL // 2
CONV_W = 3
D_AB_IN = D_POOL + 3 * D_CONV
D_SGU = D_MODEL
SGU_HEADS = 8
SGU_HD = D_SGU // SGU_HEADS
CHUNK = 128
D_FF = 4 * D_MODEL

kernel_name = "hybrid_pool_conv_sgu_decoder_step"


def rmsnorm(x, g):
    xf = x.astype(jnp.float32)
    y = xf * lax.rsqrt(jnp.mean(xf * xf, axis=-1, keepdims=True) + EPS) * g.astype(jnp.float32)
    return y.astype(x.dtype)


def pool_mixer(u, prev, start_pos, w_grp, scale):
    b, s, _ = u.shape
    full = jnp.concatenate([prev.astype(u.dtype), u], axis=1)
    cs = jnp.cumsum(full.astype(jnp.float32), axis=1)
    cs = jnp.concatenate([jnp.zeros_like(cs[:, :1]), cs], axis=1)
    hi = cs[:, POOL_PREV + 1:]
    pos = (jnp.arange(s) + start_pos).astype(jnp.float32)
    outs = []
    for g, w in enumerate(POOL_WINDOWS):
        sl = slice(g * POOL_GC, (g + 1) * POOL_GC)
        lo = cs[:, POOL_PREV + 1 - w:POOL_PREV + 1 - w + s, sl]
        cnt = jnp.minimum(pos + 1.0, float(w))[None, :, None]
        outs.append((hi[..., sl] - lo) / cnt - u[..., sl].astype(jnp.float32))
    d = jnp.stack(outs, axis=2).astype(u.dtype)
    y = jnp.einsum('bsgc,gcd->bsgd', d, w_grp).reshape(b, s, D_POOL) * scale
    return y, full[:, -POOL_PREV:]


def short_conv(z, prev, w):
    s = z.shape[1]
    full = jnp.concatenate([prev.astype(z.dtype), z], axis=1)
    out = w[0] * full[:, :s]
    for k in range(1, CONV_W):
        out = out + w[k] * full[:, k:k + s]
    return out, full[:, -(CONV_W - 1):]


def pool_conv_mixer(h, pool_prev, conv_prev, start_pos, w_in, w_grp, scale, conv_w, w_out):
    p = h @ w_in
    u = p[..., :D_POOL]
    xb = p[..., D_POOL:D_POOL + D_CONV]
    gate_b = p[..., D_POOL + D_CONV:D_POOL + 2 * D_CONV]
    gate_c = p[..., D_POOL + 2 * D_CONV:]
    ya, new_pool = pool_mixer(u, pool_prev, start_pos, w_grp, scale)
    cz, new_conv = short_conv(gate_c * xb, conv_prev, conv_w)
    yb = gate_b * cz
    return jnp.concatenate([ya, yb], axis=-1) @ w_out, new_pool, new_conv


def chunk_spatial(v, w_s, b_s):
    b, s, h, hd = v.shape
    mask = jnp.tril(jnp.ones((CHUNK, CHUNK), dtype=w_s.dtype))
    wm = w_s * mask
    if s < CHUNK:
        out = jnp.einsum('hts,bshd->bthd', wm[:, :s, :s], v)
        return out + jnp.transpose(b_s[:, :s])[None, :, :, None]
    n = -(-s // CHUNK)
    vp = jnp.pad(v, ((0, 0), (0, n * CHUNK - s), (0, 0), (0, 0))).reshape(b, n, CHUNK, h, hd)
    out = jnp.einsum('hts,bnshd->bnthd', wm, vp) + jnp.transpose(b_s)[None, None, :, :, None]
    return out.reshape(b, n * CHUNK, h, hd)[:, :s]


def chunk_mlp_mixer(h, w_uv, g_v, w_s, b_s, w_out):
    b, s, _ = h.shape
    p = h @ w_uv
    u = p[..., :D_SGU]
    v = rmsnorm(p[..., D_SGU:], g_v)
    sv = chunk_spatial(v.reshape(b, s, SGU_HEADS, SGU_HD), w_s, b_s).reshape(b, s, D_SGU)
    return (u * sv) @ w_out, v


def trunk(x, pool_prev, conv_prev, start_pos,
          g_mix_pre, g_mix_post, g_ffn_pre, g_ffn_post,
          w_in_ab, w_pool_grp, pool_scale, conv_w, w_out_ab,
          w_uv, g_v, w_spatial, b_spatial, w_out_c, w_up, w_down):
    new_pool, new_conv, new_v = [], [], []
    for l in range(DEPTH):
        h = rmsnorm(x, g_mix_pre[l])
        if l % 2 == 0:
            i = l // 2
            m, npool, nconv = pool_conv_mixer(h, pool_prev[i], conv_prev[i], start_pos,
                                              w_in_ab[i], w_pool_grp[i], pool_scale[i],
                                              conv_w[i], w_out_ab[i])
            new_pool.append(npool)
            new_conv.append(nconv)
        else:
            i = l // 2
            m, v = chunk_mlp_mixer(h, w_uv[i], g_v[i], w_spatial[i], b_spatial[i], w_out_c[i])
            new_v.append(v)
        x = x + rmsnorm(m, g_mix_post[l])
        h = rmsnorm(x, g_ffn_pre[l])
        f = jnp.square(jax.nn.relu(h @ w_up[l])) @ w_down[l]
        x = x + rmsnorm(f, g_ffn_post[l])
    return x, jnp.stack(new_pool), jnp.stack(new_conv), jnp.stack(new_v)


def setup_inputs(seed: int = 0) -> dict:
    key = jax.random.key(seed)
    ks = jax.random.split(key, 24)
    nrm = lambda k, shape, sc: jax.random.normal(k, shape, jnp.float32) * sc
    gain = lambda k, shape: 1.0 + 0.05 * jax.random.normal(k, shape, jnp.float32)
    return {
        "x_prompt": nrm(ks[0], (BATCH, SEQ, D_MODEL), 1.0),
        "x_sample": nrm(ks[1], (DEC_BATCH, DEC_SEQ, D_MODEL), 1.0),
        "state_pool": nrm(ks[2], (N_EVEN, DEC_BATCH, POOL_PREV, D_POOL), 1.0),
        "state_conv": nrm(ks[3], (N_EVEN, DEC_BATCH, CONV_W - 1, D_CONV), 1.0),
        "g_mix_pre": gain(ks[4], (DEPTH, D_MODEL)),
        "g_mix_post": gain(ks[5], (DEPTH, D_MODEL)),
        "g_ffn_pre": gain(ks[6], (DEPTH, D_MODEL)),
        "g_ffn_post": gain(ks[7], (DEPTH, D_MODEL)),
        "w_in_ab": nrm(ks[8], (N_EVEN, D_MODEL, D_AB_IN), D_MODEL ** -0.5),
        "w_pool_grp": nrm(ks[9], (N_EVEN, POOL_GROUPS, POOL_GC, POOL_GC), POOL_GC ** -0.5),
        "pool_scale": gain(ks[10], (N_EVEN, D_POOL)),
        "conv_w": nrm(ks[11], (N_EVEN, CONV_W, D_CONV), CONV_W ** -0.5),
        "w_out_ab": nrm(ks[12], (N_EVEN, D_POOL + D_CONV, D_MODEL), (D_POOL + D_CONV) ** -0.5),
        "w_uv": nrm(ks[13], (N_ODD, D_MODEL, 2 * D_SGU), D_MODEL ** -0.5),
        "g_v": gain(ks[14], (N_ODD, D_SGU)),
        "w_spatial": nrm(ks[15], (N_ODD, SGU_HEADS, CHUNK, CHUNK), CHUNK ** -0.5),
        "b_spatial": gain(ks[16], (N_ODD, SGU_HEADS, CHUNK)),
        "w_out_c": nrm(ks[17], (N_ODD, D_SGU, D_MODEL), D_SGU ** -0.5),
        "w_up": nrm(ks[18], (DEPTH, D_MODEL, D_FF), D_MODEL ** -0.5),
        "w_down": nrm(ks[19], (DEPTH, D_FF, D_MODEL), D_FF ** -0.5),
    }


def reference(x_prompt, x_sample, state_pool, state_conv,
              g_mix_pre, g_mix_post, g_ffn_pre, g_ffn_post,
              w_in_ab, w_pool_grp, pool_scale, conv_w, w_out_ab,
              w_uv, g_v, w_spatial, b_spatial, w_out_c, w_up, w_down):
    b = x_prompt.shape[0]
    zero_pool = jnp.zeros((N_EVEN, b, POOL_PREV, D_POOL), x_prompt.dtype)
    zero_conv = jnp.zeros((N_EVEN, b, CONV_W - 1, D_CONV), x_prompt.dtype)
    y_prompt, pool_p, conv_p, _ = trunk(
        x_prompt, zero_pool, zero_conv, 0,
        g_mix_pre, g_mix_post, g_ffn_pre, g_ffn_post,
        w_in_ab, w_pool_grp, pool_scale, conv_w, w_out_ab,
        w_uv, g_v, w_spatial, b_spatial, w_out_c, w_up, w_down)
    y_sample, pool_s, conv_s, v_s = trunk(
        x_sample, state_pool, state_conv, PAST_LEN,
        g_mix_pre, g_mix_post, g_ffn_pre, g_ffn_post,
        w_in_ab, w_pool_grp, pool_scale, conv_w, w_out_ab,
        w_uv, g_v, w_spatial, b_spatial, w_out_c, w_up, w_down)
    return (y_prompt, y_sample, pool_p, pool_s, conv_p, conv_s, v_s)
```

```cpp
#include <hip/hip_runtime.h>
#include <cstdio>
#include <cstdint>
namespace pg8 {
#define PG8_LAS __attribute__((address_space(3)))
typedef unsigned short bf16_t;
typedef short bf16x8 __attribute__((ext_vector_type(8)));
typedef float f32x4 __attribute__((ext_vector_type(4)));
typedef unsigned u32x4 __attribute__((ext_vector_type(4)));
constexpr int BM = 256, BK = 64, HALF = 128, HTB = HALF * BK * 2  , STAGE_BYTES = 8 * HTB, NXCD = 8, WGM = 8;

__host__ __device__ __forceinline__ int lds_byte(int r, int c) { const int st = (r >> 4) * 2 + (c >> 5), rr = r & 15, cc = c & 31, ob = rr * 64 + cc * 2; return st * 1024 + (ob ^ (((ob >> 9) & 1) << 5)); }
__host__ __device__ __forceinline__ void stage_rc(int b, int& R, int& C) { const int st = b / 1024, sb = b % 1024, swz = sb ^ (((sb >> 9) & 1) << 5); R = (st >> 1) * 16 + swz / 64; C = (st & 1) * 32 + (swz % 64) / 2; }
__host__ __device__ __forceinline__ int perm32(int rho) { const int n = rho >> 4, i = rho & 15; return 8 * (i >> 2) + 4 * n + (i & 3); }

struct Unit { int pm, pn; };
struct Gemm { const bf16_t* A; const bf16_t* Bt; int M, N, K; };

struct StaticOrder {
    int nM, nN, nwg, G, c;
    __host__ __device__ void init(int M, int N, int G_, int c_) { nM = M / BM; nN = N / BM; nwg = nM * nN; G = G_; c = c_; }
    __host__ __device__ bool next(int i, Unit& u) const {
        const long L = (long)i * G + c; if (L >= nwg) return false;
        int wgid = (int)L; { const int q = nwg / NXCD, r = nwg % NXCD, xcd = wgid % NXCD, off = wgid / NXCD; wgid = (xcd < r ? xcd * (q + 1) : r * (q + 1) + (xcd - r) * q) + off; }
        const int nig = WGM * nN, gid = wgid / nig, fm = gid * WGM, gsz = (nM - fm) < WGM ? (nM - fm) : WGM;
        u.pm = fm + ((wgid % nig) % gsz); u.pn = (wgid % nig) / gsz; return true;
    }
    __device__ __forceinline__ void a_ready(const Unit&) const {}
    __device__ __forceinline__ void done(const Unit&) const {}
};


__device__ __forceinline__ unsigned cvt_pk_bf16(float lo, float hi) { unsigned r; asm volatile("v_cvt_pk_bf16_f32 %0, %1, %2" : "=v"(r) : "v"(lo), "v"(hi)); return r; }

struct EpiBf16 {
    static constexpr bool PERM = true, AFTER_DRAIN = false;
    bf16_t* O; int ldc; int act;
    __device__ __forceinline__ void operator()(const f32x4 (&acc)[2][2][4][2], const Unit& u, int wr, int wc, int fr, int fq) const {
        const int row0 = u.pm * BM + wr * 64 + fr; const int col0 = u.pn * BM + wc * 32 + 8 * fq;
#pragma unroll
        for (int ai = 0; ai < 2; ++ai)
#pragma unroll
            for (int m = 0; m < 4; ++m) { bf16_t* rowp = O + (size_t)(row0 + ai * HALF + m * 16) * ldc + col0;
#pragma unroll
                for (int bj = 0; bj < 2; ++bj) { f32x4 v0 = acc[ai][bj][m][0], v1 = acc[ai][bj][m][1];
                    if (act) {
#pragma unroll
                        for (int j = 0; j < 4; ++j) { const float a = fmaxf(v0[j], 0.f), b = fmaxf(v1[j], 0.f); v0[j] = a * a; v1[j] = b * b; } }
                    u32x4 w; w.x = cvt_pk_bf16(v0[0], v0[1]); w.y = cvt_pk_bf16(v0[2], v0[3]); w.z = cvt_pk_bf16(v1[0], v1[1]); w.w = cvt_pk_bf16(v1[2], v1[3]);
                    *(u32x4*)(rowp + bj * HALF) = w; } }
    }
};

template <class Epi, class Sched, bool ALIGN_EPI = false, bool SP2 = false>
__device__ __forceinline__ void gemm_phase(PG8_LAS unsigned char* lds, const Gemm g, const Sched& S, const Epi& E, const int tid) {
    const int wid = __builtin_amdgcn_readfirstlane(tid >> 6), lane = tid & 63, wr = wid >> 2, wc = wid & 3, fr = lane & 15, fq = lane >> 4;
    const int K = g.K, nt = K / BK;
    unsigned voffA[2], voffB[2];
#pragma unroll
    for (int i = 0; i < 2; ++i) { int R, C; stage_rc(tid * 16 + i * 8192, R, C); const int Rb = Epi::PERM ? ((R & ~31) + perm32(R & 31)) : R;
        voffA[i] = (unsigned)(R * K + C) * 2u; voffB[i] = (unsigned)(Rb * K + C) * 2u; }
    const size_t kstep = (size_t)(BK * 2);
    const size_t hstep = (size_t)HALF * K * 2;
    const size_t tstep = 2 * hstep;
    const unsigned ldsw = (unsigned)wid * 1024u;
    const int aoff = lds_byte(wr * 64 + fr, fq * 8), boff = lds_byte(wc * 32 + fr, fq * 8);
#define PG8_SA(b, h) (((b) * 2 + (h)) * HTB)
#define PG8_SB(b, h) ((4 + (b) * 2 + (h)) * HTB)
#define PG8_STAGE(bufoff, gbase, voff) do { _Pragma("unroll") for (int _i = 0; _i < 2; ++_i) \
        __builtin_amdgcn_global_load_lds((const unsigned*)((const char*)(gbase) + (voff)[_i]), (PG8_LAS unsigned*)(lds + (bufoff) + ldsw + _i * 8192), 16, 0, 0); } while (0)
#define PG8_LDA(dst, b, h) do { _Pragma("unroll") for (int m = 0; m < 4; ++m) _Pragma("unroll") for (int k = 0; k < 2; ++k) dst[m][k] = *(const PG8_LAS bf16x8*)(lds + PG8_SA(b, h) + aoff + m * 2048 + k * 1024); } while (0)
#define PG8_LDB(dst, b, h) do { _Pragma("unroll") for (int n = 0; n < 2; ++n) _Pragma("unroll") for (int k = 0; k < 2; ++k) dst[n][k] = *(const PG8_LAS bf16x8*)(lds + PG8_SB(b, h) + boff + n * 2048 + k * 1024); } while (0)
#define PG8_MMA(ai, bj, At, Bt) do { __builtin_amdgcn_s_setprio(1); _Pragma("unroll") for (int m = 0; m < 4; ++m) _Pragma("unroll") for (int n = 0; n < 2; ++n) _Pragma("unroll") for (int k = 0; k < 2; ++k) \
        acc[ai][bj][m][n] = __builtin_amdgcn_mfma_f32_16x16x32_bf16(Bt[n][k], At[m][k], acc[ai][bj][m][n], 0, 0, 0); __builtin_amdgcn_s_setprio(0); } while (0)
#define PG8_WAIT_V(n) asm volatile("s_waitcnt vmcnt(" #n ")" ::: "memory")
#define PG8_WAIT_L(n) asm volatile("s_waitcnt lgkmcnt(" #n ")" ::: "memory")
#define PG8_BAR __builtin_amdgcn_s_barrier()
#define PG8_SCHED __builtin_amdgcn_sched_barrier(0)
    Unit cur, nxt; int ui = 0;
    if (!S.next(0, cur)) return;
    f32x4 acc[2][2][4][2];
#pragma unroll
    for (int a = 0; a < 2; ++a)
#pragma unroll
        for (int b = 0; b < 2; ++b)
#pragma unroll
            for (int m = 0; m < 4; ++m)
#pragma unroll
                for (int n = 0; n < 2; ++n) acc[a][b][m][n] = (f32x4){0.f, 0.f, 0.f, 0.f};
    bf16x8 At[4][2], B0[2][2], B1[2][2];
    const char* cA = (const char*)g.A + (size_t)cur.pm * tstep; const char* cB = (const char*)g.Bt + (size_t)cur.pn * tstep;
    S.a_ready(cur);
    if constexpr (SP2) {
        PG8_STAGE(PG8_SB(0, 0), cB, voffB); PG8_STAGE(PG8_SB(0, 1), cB + hstep, voffB); PG8_STAGE(PG8_SA(0, 0), cA, voffA); PG8_STAGE(PG8_SA(0, 1), cA + hstep, voffA);
        if (wr == 1) PG8_BAR;
        PG8_WAIT_V(2); PG8_BAR;
        PG8_STAGE(PG8_SB(1, 0), cB + kstep, voffB); PG8_STAGE(PG8_SA(1, 0), cA + kstep, voffA); PG8_STAGE(PG8_SB(1, 1), cB + hstep + kstep, voffB);
        PG8_WAIT_V(6); PG8_BAR;
    } else {
        PG8_STAGE(PG8_SB(0, 0), cB, voffB); PG8_STAGE(PG8_SA(0, 0), cA, voffA); PG8_STAGE(PG8_SB(0, 1), cB + hstep, voffB); PG8_STAGE(PG8_SA(0, 1), cA + hstep, voffA);
        if (wr == 1) PG8_BAR;
        PG8_WAIT_V(4); PG8_BAR;
        PG8_STAGE(PG8_SB(1, 0), cB + kstep, voffB); PG8_STAGE(PG8_SA(1, 0), cA + kstep, voffA); PG8_STAGE(PG8_SB(1, 1), cB + hstep + kstep, voffB);
        PG8_WAIT_V(6); PG8_BAR;
    }
    for (;;) {
        const bool has_next = S.next(ui + 1, nxt);
        const char* nA = has_next ? (const char*)g.A + (size_t)nxt.pm * tstep : cA; const char* nB = has_next ? (const char*)g.Bt + (size_t)nxt.pn * tstep : cB;
        for (int t = 0; t < nt; t += 2) {
            const bool last = (t == nt - 2);
            const char* a1 = cA + (size_t)(t + 1) * kstep;
            const char* a2 = last ? nA : cA + (size_t)(t + 2) * kstep; const char* b2 = last ? nB : cB + (size_t)(t + 2) * kstep;
            const char* a3 = a2 + kstep; const char* b3 = b2 + kstep;
            if (last && has_next) S.a_ready(nxt);
            if constexpr (SP2) {
            PG8_LDB(B0, 0, 0); PG8_LDB(B1, 0, 1); PG8_SCHED; PG8_LDA(At, 0, 0); PG8_STAGE(PG8_SA(1, 1), a1 + hstep, voffA);
            PG8_WAIT_V(8); PG8_WAIT_L(0); PG8_BAR; PG8_MMA(0, 0, At, B0); PG8_MMA(0, 1, At, B1); PG8_BAR; PG8_SCHED;
            PG8_LDA(At, 0, 1); PG8_STAGE(PG8_SB(0, 0), b2, voffB); PG8_STAGE(PG8_SB(0, 1), b2 + hstep, voffB); PG8_STAGE(PG8_SA(0, 0), a2, voffA);
            PG8_WAIT_V(8); PG8_WAIT_L(0); PG8_BAR; PG8_MMA(1, 0, At, B0); PG8_MMA(1, 1, At, B1); PG8_BAR; PG8_SCHED;
            PG8_LDB(B0, 1, 0); PG8_LDB(B1, 1, 1); PG8_SCHED; PG8_LDA(At, 1, 0); PG8_STAGE(PG8_SA(0, 1), a2 + hstep, voffA);
            PG8_WAIT_V(8); PG8_WAIT_L(0); PG8_BAR; PG8_MMA(0, 0, At, B0); PG8_MMA(0, 1, At, B1); PG8_BAR; PG8_SCHED;
            PG8_LDA(At, 1, 1); PG8_STAGE(PG8_SB(1, 0), b3, voffB); PG8_STAGE(PG8_SB(1, 1), b3 + hstep, voffB); PG8_STAGE(PG8_SA(1, 0), a3, voffA);
            PG8_WAIT_V(8); PG8_WAIT_L(0); PG8_BAR; PG8_MMA(1, 0, At, B0); PG8_MMA(1, 1, At, B1); PG8_BAR; PG8_SCHED;
            } else {
            PG8_LDB(B0, 0, 0); PG8_SCHED; PG8_LDA(At, 0, 0); PG8_STAGE(PG8_SA(1, 1), a1 + hstep, voffA);
            PG8_WAIT_L(8); PG8_BAR; PG8_WAIT_L(0); PG8_MMA(0, 0, At, B0); PG8_BAR; PG8_SCHED;
            PG8_LDB(B1, 0, 1); PG8_STAGE(PG8_SB(0, 0), b2, voffB);
            PG8_BAR; PG8_WAIT_L(0); PG8_MMA(0, 1, At, B1); PG8_BAR;
            PG8_LDA(At, 0, 1); PG8_STAGE(PG8_SA(0, 0), a2, voffA);
            PG8_BAR; PG8_WAIT_L(0); PG8_MMA(1, 0, At, B0); PG8_BAR; PG8_SCHED;
            PG8_STAGE(PG8_SB(0, 1), b2 + hstep, voffB);
            PG8_WAIT_V(6); PG8_BAR; PG8_MMA(1, 1, At, B1); PG8_BAR;
            PG8_LDB(B0, 1, 0); PG8_SCHED; PG8_LDA(At, 1, 0); PG8_STAGE(PG8_SA(0, 1), a2 + hstep, voffA);
            PG8_WAIT_L(8); PG8_BAR; PG8_WAIT_L(0); PG8_MMA(0, 0, At, B0); PG8_BAR; PG8_SCHED;
            PG8_LDB(B1, 1, 1); PG8_STAGE(PG8_SB(1, 0), b3, voffB);
            PG8_BAR; PG8_WAIT_L(0); PG8_MMA(0, 1, At, B1); PG8_BAR;
            PG8_LDA(At, 1, 1); PG8_STAGE(PG8_SA(1, 0), a3, voffA);
            PG8_BAR; PG8_WAIT_L(0); PG8_MMA(1, 0, At, B0); PG8_BAR; PG8_SCHED;
            PG8_STAGE(PG8_SB(1, 1), b3 + hstep, voffB);
            PG8_WAIT_V(6); PG8_BAR; PG8_MMA(1, 1, At, B1); PG8_BAR;
            }
        }
        if constexpr (ALIGN_EPI) { if (wr == 0) PG8_BAR; }
        if constexpr (!Epi::AFTER_DRAIN) { E(acc, cur, wr, wc, fr, fq); S.done(cur); }
        if (!has_next) break;
#pragma unroll
        for (int a = 0; a < 2; ++a)
#pragma unroll
            for (int b = 0; b < 2; ++b)
#pragma unroll
                for (int m = 0; m < 4; ++m)
#pragma unroll
                    for (int n = 0; n < 2; ++n) acc[a][b][m][n] = (f32x4){0.f, 0.f, 0.f, 0.f};
        cur = nxt; cA = nA; cB = nB; ++ui;
        if constexpr (ALIGN_EPI) { if (wr == 1) PG8_BAR; }
    }
    PG8_WAIT_V(0);
    if constexpr (!ALIGN_EPI) { if (wr == 0) PG8_BAR; }
    PG8_BAR;
    if constexpr (Epi::AFTER_DRAIN) { E.fused(acc, cur, wr, wc, fr, fq, lds, wid, lane); S.done(cur); }
#undef PG8_SA
#undef PG8_SB
#undef PG8_STAGE
#undef PG8_LDA
#undef PG8_LDB
#undef PG8_MMA
#undef PG8_WAIT_V
#undef PG8_WAIT_L
#undef PG8_BAR
#undef PG8_SCHED
}
}

#ifndef PG8_SP2
#define PG8_SP2 true
#endif
#ifndef PG8_ALIGN
#define PG8_ALIGN true
#endif
constexpr int NWAVES = 8;

constexpr int D = 1024, NB = 8, SEQ = 2048, NSB = 128, SSEQ = 8;
constexpr int MP = NB * SEQ, MS = NSB * SSEQ, M = MP + MS;
constexpr int DAB = 2048, FF = 4096;
constexpr float EPS = 1e-6f;
constexpr size_t O_POOLP = (size_t)M * D, O_POOLS = O_POOLP + 8 * 15 * 512, O_CONVP = O_POOLS + 128 * 15 * 512, O_CONVS = O_CONVP + 8 * 2 * 512, O_V = O_CONVS + 128 * 2 * 512, O_END = O_V + 128 * 8 * 1024;

constexpr size_t MiB = 1u << 20;
constexpr size_t WS_CTL = 0, CTL_ZERO_BYTES = 1 * MiB;
constexpr size_t WS_WIN = 2 * MiB, WS_WOAB = 6 * MiB, WS_WUV = 8 * MiB, WS_WOC = 12 * MiB, WS_WUP = 14 * MiB, WS_WDN = 30 * MiB;
constexpr size_t WS_WGRP = 46 * MiB, WS_WSP = 46 * MiB + 128 * 1024;
constexpr size_t WS_XN = 47 * MiB;
constexpr size_t WS_MF2 = 81 * MiB;
constexpr size_t WS_H = 115 * MiB;
constexpr size_t WS_P = 115 * MiB, WS_A3 = 183 * MiB, WS_MF = 217 * MiB, WS_END = 251 * MiB;
static_assert(WS_H + (size_t)M * FF * 2 == WS_END && WS_P + (size_t)M * DAB * 2 == WS_A3 && WS_A3 + (size_t)M * D * 2 == WS_MF && WS_MF + (size_t)M * D * 2 == WS_END && WS_XN + (size_t)M * D * 2 == WS_MF2 && WS_MF2 + (size_t)M * D * 2 == WS_H, "d_ws map");
constexpr int CW_TMO = 0, CW_CODE = 1, CW_BAR = 4096;

constexpr int RING_OFF = 0, RING_BYTES = 131072;
constexpr int LDSCTL_OFF = RING_BYTES, MISC_OFF = LDSCTL_OFF + 320;
constexpr int LDS_BYTES = 147456;

#define GAS __attribute__((address_space(1)))
#define LAS __attribute__((address_space(3)))
typedef unsigned short bf16;
typedef unsigned v4u __attribute__((ext_vector_type(4)));
typedef unsigned v2u __attribute__((ext_vector_type(2)));
typedef float f32x4 __attribute__((ext_vector_type(4)));
typedef short bf16x8 __attribute__((ext_vector_type(8)));
typedef GAS unsigned gu32;
#define RLX_AGENT __ATOMIC_RELAXED, __HIP_MEMORY_SCOPE_AGENT
#define LDS_WAIT() asm volatile("s_waitcnt lgkmcnt(0)" ::: "memory")
#define VM_WAIT() asm volatile("s_waitcnt vmcnt(0)" ::: "memory")
__device__ __forceinline__ unsigned f2bf(float f) { unsigned u = __builtin_bit_cast(unsigned, f); return (u + 0x7fffu + ((u >> 16) & 1u)) >> 16; }
__device__ __forceinline__ unsigned pk2(float lo, float hi) { return pg8::cvt_pk_bf16(lo, hi); }
__device__ __forceinline__ float bf2f(unsigned short h) { return __uint_as_float((unsigned)h << 16); }
__device__ __forceinline__ float bflo(unsigned w) { return __uint_as_float(w << 16); }
__device__ __forceinline__ float bfhi(unsigned w) { return __uint_as_float(w & 0xffff0000u); }
__device__ __forceinline__ void unpack8(const v4u a, float (&v)[8]) { v[0] = bflo(a.x); v[1] = bfhi(a.x); v[2] = bflo(a.y); v[3] = bfhi(a.y); v[4] = bflo(a.z); v[5] = bfhi(a.z); v[6] = bflo(a.w); v[7] = bfhi(a.w); }

__device__ __forceinline__ int irow_p(int b, int t) { return b * SEQ + t; }
__device__ __forceinline__ int irow_s(int b, int t) { return MP + b * SSEQ + t; }
__device__ __forceinline__ int nat_row(int r) { return r; }

#define XB_TMO      128
#define XB_XCNT(j)  (256  + 64 * (j))
#define XB_XSUB(j)  (1280 + 64 * (j))
#define XB_XGEN(j)  (2304 + 64 * (j))
#define XB_TOP      3328
#define XB_TOPGEN   3392
#define XCD_BAR_WORDS 3456
#define XB_SPIN_CAP (1u << 18)

__device__ __forceinline__ unsigned xb_ld(unsigned* p)              { return __hip_atomic_load(p, __ATOMIC_RELAXED, __HIP_MEMORY_SCOPE_AGENT); }
__device__ __forceinline__ unsigned xb_add(unsigned* p, unsigned v) { return __hip_atomic_fetch_add(p, v, __ATOMIC_RELAXED, __HIP_MEMORY_SCOPE_AGENT); }
__device__ __forceinline__ unsigned xb_xcc_id() { return (unsigned)__builtin_amdgcn_s_getreg((3 << 11) | 20) & 0xFu; }
#define XB_SPIN(cond, bar) do { unsigned _sp = 0; while (cond) { __builtin_amdgcn_s_sleep(1); \
    if ((++_sp & 255u) == 0u) { if (xb_ld(&(bar)[XB_TMO])) break; if (_sp > XB_SPIN_CAP) { atomicAdd(&(bar)[XB_TMO], 1u); break; } } } } while (0)

struct XcdBarrier {
    unsigned* bar; unsigned x;
    volatile LAS unsigned* st;
};

__device__ __forceinline__ XcdBarrier xcd_barrier_post(unsigned* bar, volatile LAS unsigned* st) {
    XcdBarrier b; b.bar = bar; b.x = xb_xcc_id(); b.st = st;
    if (threadIdx.x == 0) (void)xb_add(&bar[XB_XCNT(b.x)], 1u);
    return b;
}
__device__ __forceinline__ void xcd_barrier_complete(unsigned* bar, unsigned x, unsigned& nloc, unsigned& nx) {
    const unsigned G = gridDim.x * gridDim.y * gridDim.z;
    unsigned sum, cnt, mine, sp = 0u;
    for (;;) {
        sum = 0u; cnt = 0u; mine = 0u;
#pragma unroll
        for (unsigned j = 0; j < 16; ++j) { const unsigned c = xb_ld(&bar[XB_XCNT(j)]); sum += c; cnt += (c > 0u) ? 1u : 0u; mine = (j == x) ? c : mine; }
        if (sum == G) break;
        __builtin_amdgcn_s_sleep(1);
        if ((++sp & 255u) == 0u) { if (xb_ld(&bar[XB_TMO])) break; if (sp > XB_SPIN_CAP) { atomicAdd(&bar[XB_TMO], 1u); break; } }
    }
    nloc = mine > 0u ? mine : 1u; nx = cnt > 0u ? cnt : 1u;
}

__device__ __forceinline__ void xcd_barrier(const XcdBarrier& b) {
    asm volatile("s_waitcnt vmcnt(0)" ::: "memory");
    __syncthreads();
    if (threadIdx.x == 0) {
        unsigned* bar = b.bar;
        __builtin_amdgcn_s_waitcnt(0);
        unsigned nloc = b.st[0], nx = b.st[1];
        if (nloc == 0u) { xcd_barrier_complete(bar, b.x, nloc, nx); b.st[0] = nloc; b.st[1] = nx; }
        const unsigned old = xb_add(&bar[XB_XSUB(b.x)], 1u);
        const unsigned gen = old / nloc;
        if (old + 1u == (gen + 1u) * nloc) {
            __builtin_amdgcn_fence(__ATOMIC_RELEASE, "agent");
            asm volatile("s_waitcnt vmcnt(0)" ::: "memory");
            const unsigned og = xb_add(&bar[XB_TOP], 1u);
            const unsigned tg = og / nx;
            if (og + 1u == (tg + 1u) * nx) xb_add(&bar[XB_TOPGEN], 1u);
            else XB_SPIN(xb_ld(&bar[XB_TOPGEN]) == tg, bar);
            __builtin_amdgcn_fence(__ATOMIC_ACQUIRE, "agent");
            xb_add(&bar[XB_XGEN(b.x)], 1u);
            asm volatile("s_waitcnt vmcnt(0)" ::: "memory");
        } else {
            XB_SPIN(xb_ld(&bar[XB_XGEN(b.x)]) == gen, bar);
            __builtin_amdgcn_fence(__ATOMIC_ACQUIRE, "agent");
            asm volatile("s_waitcnt vmcnt(0)" ::: "memory");
        }
    }
    __syncthreads();
}

struct Frame {
    LAS unsigned char* lds;
    volatile LAS unsigned* MISC;
    gu32* ctl;
    int tid, lane, wave;
    int vcu, G;
    const float *xp, *xs, *spool, *sconv, *g_mix_pre, *g_mix_post, *g_ffn_pre, *g_ffn_post, *w_in, *w_grp, *pool_scale, *conv_w, *w_oab, *w_uv, *g_v, *w_sp, *b_sp, *w_oc, *w_up, *w_dn;
    float* out;
    bf16 *Win_t, *Woab_t, *Wuv_t, *Woc_t, *Wup_t, *Wdn_t, *Wg_t, *Wsp;
    bf16 *XN, *P, *A3, *MF, *MF2, *H;
};

__device__ __forceinline__ float wave_sum(float v) {
#pragma unroll
    for (int o = 1; o < 64; o <<= 1) v += __shfl_xor(v, o);
    return v;
}
__device__ __forceinline__ void ld_row_f32(const float* row, int lane, f32x4 (&v)[4]) { const GAS f32x4* p = (const GAS f32x4*)row + 2 * lane; v[0] = p[0]; v[1] = p[1]; v[2] = p[128]; v[3] = p[129]; }
__device__ __forceinline__ void st_row_f32(float* row, int lane, const f32x4 (&v)[4]) { GAS f32x4* p = (GAS f32x4*)row + 2 * lane; p[0] = v[0]; p[1] = v[1]; p[128] = v[2]; p[129] = v[3]; }
__device__ __forceinline__ void ld_row_bf16(const bf16* row, int lane, f32x4 (&v)[4]) {
    const GAS v4u* p = (const GAS v4u*)row + lane; const v4u a = p[0], b = p[64];
    v[0] = (f32x4){bflo(a.x), bfhi(a.x), bflo(a.y), bfhi(a.y)}; v[1] = (f32x4){bflo(a.z), bfhi(a.z), bflo(a.w), bfhi(a.w)};
    v[2] = (f32x4){bflo(b.x), bfhi(b.x), bflo(b.y), bfhi(b.y)}; v[3] = (f32x4){bflo(b.z), bfhi(b.z), bflo(b.w), bfhi(b.w)};
}
__device__ __forceinline__ void st_row_bf16(bf16* row, int lane, const f32x4 (&v)[4]) {
    GAS v4u* p = (GAS v4u*)row + lane;
    p[0] = (v4u){pk2(v[0][0], v[0][1]), pk2(v[0][2], v[0][3]), pk2(v[1][0], v[1][1]), pk2(v[1][2], v[1][3])};
    p[64] = (v4u){pk2(v[2][0], v[2][1]), pk2(v[2][2], v[2][3]), pk2(v[3][0], v[3][1]), pk2(v[3][2], v[3][3])};
}
__device__ __forceinline__ float sumsq4(const f32x4 (&v)[4]) { float s = 0.f;
#pragma unroll
    for (int j = 0; j < 4; ++j) s += (v[j][0] * v[j][0] + v[j][1] * v[j][1]) + (v[j][2] * v[j][2] + v[j][3] * v[j][3]);
    return s; }
__device__ __forceinline__ const float* x_row(const Frame& F, int n) { return n < MP ? F.xp + (size_t)n * D : F.xs + (size_t)(n - MP) * D; }

__device__ __forceinline__ void p0_transpose_item(const float* W, int K, int N, bf16* WT, LAS float* scr, int item, int lane) {
    const int nblk = N / 32, kb = item / nblk, nb = item % nblk, k0 = 64 * kb, n0 = 32 * nb;
#pragma unroll 8
    for (int i = 0; i < 32; ++i) { const int kk = 2 * i + (lane >> 5); scr[kk * 33 + (lane & 31)] = W[(size_t)(k0 + kk) * N + n0 + (lane & 31)]; }
    LDS_WAIT(); asm volatile("" ::: "memory");
    const int c = lane & 7;
#pragma unroll
    for (int j = 0; j < 4; ++j) { const int n = (lane >> 3) + 8 * j; const LAS float* s = scr + (8 * c) * 33 + n;
        v4u o; o.x = pk2(s[0 * 33], s[1 * 33]); o.y = pk2(s[2 * 33], s[3 * 33]); o.z = pk2(s[4 * 33], s[5 * 33]); o.w = pk2(s[6 * 33], s[7 * 33]);
        *(GAS v4u*)(WT + (size_t)(n0 + n) * K + k0 + 8 * c) = o; }
    LDS_WAIT(); asm volatile("" ::: "memory");
}
__device__ __forceinline__ void p0_prologue(Frame& F) {
    LAS float* scr = (LAS float*)(F.lds + RING_OFF + F.wave * 16384);
    const int gw = F.vcu * NWAVES + F.wave, NGW = F.G * NWAVES;
    constexpr int I_IN = (D / 64) * (DAB / 32), I_OAB = (D / 64) * (D / 32), I_UP = (D / 64) * (FF / 32), I_DN = (FF / 64) * (D / 32), I_GRP = 2 * 4;
    constexpr int NITEMS = 2 * I_IN + 2 * I_OAB + 2 * I_UP + 2 * I_DN + 4 * I_GRP;
    for (int it = gw; it < NITEMS; it += NGW) {
        int r = it;
        if (r < I_IN) { p0_transpose_item(F.w_in, D, DAB, F.Win_t, scr, r, F.lane); continue; } r -= I_IN;
        if (r < I_IN) { p0_transpose_item(F.w_uv, D, DAB, F.Wuv_t, scr, r, F.lane); continue; } r -= I_IN;
        if (r < I_OAB) { p0_transpose_item(F.w_oab, D, D, F.Woab_t, scr, r, F.lane); continue; } r -= I_OAB;
        if (r < I_OAB) { p0_transpose_item(F.w_oc, D, D, F.Woc_t, scr, r, F.lane); continue; } r -= I_OAB;
        if (r < 2 * I_UP) { const int l = r / I_UP; p0_transpose_item(F.w_up + (size_t)l * D * FF, D, FF, F.Wup_t + (size_t)l * D * FF, scr, r % I_UP, F.lane); continue; } r -= 2 * I_UP;
        if (r < 2 * I_DN) { const int l = r / I_DN; p0_transpose_item(F.w_dn + (size_t)l * D * FF, FF, D, F.Wdn_t + (size_t)l * D * FF, scr, r % I_DN, F.lane); continue; } r -= 2 * I_DN;
        { const int g = r / I_GRP; p0_transpose_item(F.w_grp + (size_t)g * 128 * 128, 128, 128, F.Wg_t + (size_t)g * 128 * 128, scr, r % I_GRP, F.lane); }
    }
    for (int e = F.vcu * (NWAVES * 64) + F.tid; e < 8 * 128 * 128; e += F.G * NWAVES * 64) { const int t = (e >> 7) & 127, s = e & 127; F.Wsp[e] = (bf16)f2bf(s <= t ? F.w_sp[e] : 0.f); }
    f32x4 G1[4]; ld_row_f32(F.g_mix_pre, F.lane, G1);
    for (int r = gw; r < M; r += NGW) {
        f32x4 v[4]; ld_row_f32(x_row(F, nat_row(r)), F.lane, v);
        const float rs = rsqrtf(wave_sum(sumsq4(v)) * (1.f / D) + EPS);
#pragma unroll
        for (int j = 0; j < 4; ++j) v[j] = v[j] * rs * G1[j];
        st_row_bf16(F.XN + (size_t)r * D, F.lane, v);
    }
}

__device__ __forceinline__ void norm_phase(Frame& F, const bf16* MFb, const float* g1, const float* g2, bool first, bool last) {
    const int gw = F.vcu * NWAVES + F.wave, NGW = F.G * NWAVES;
    f32x4 G1[4], G2[4]; ld_row_f32(g1, F.lane, G1); ld_row_f32(g2, F.lane, G2);
    for (int r = gw; r < M; r += NGW) {
        const int n = nat_row(r);
        const float* base = first ? x_row(F, n) : (const float*)(F.out + (size_t)n * D);
        f32x4 m[4], x[4]; ld_row_bf16(MFb + (size_t)r * D, F.lane, m); ld_row_f32(base, F.lane, x);
        const float r1 = rsqrtf(wave_sum(sumsq4(m)) * (1.f / D) + EPS);
#pragma unroll
        for (int j = 0; j < 4; ++j) x[j] = x[j] + (m[j] * r1) * G1[j];
        st_row_f32(F.out + (size_t)n * D, F.lane, x);
        if (!last) {
            const float r2 = rsqrtf(wave_sum(sumsq4(x)) * (1.f / D) + EPS);
#pragma unroll
            for (int j = 0; j < 4; ++j) m[j] = (x[j] * r2) * G2[j];
            st_row_bf16(F.XN + (size_t)r * D, F.lane, m);
        }
    }
}

__device__ __forceinline__ void pool_unit(Frame& F, int pm, int g) {
    LAS unsigned char* U = F.lds; LAS unsigned char* Dt = F.lds + 36864; LAS unsigned char* Wl = F.lds + 69632;
    const int b = pm >> 3, t0 = (pm & 7) * 256, w = 2 << g;
    const int tid = F.tid, fr = F.lane & 15, fq = F.lane >> 4;
    { const GAS v4u* src = (const GAS v4u*)(F.Wg_t + (size_t)g * 128 * 128);
      for (int e = tid; e < 2048; e += NWAVES * 64) { const int n = e >> 4, sl = e & 15; *(LAS v4u*)(Wl + n * 256 + ((sl ^ (n & 15)) << 4)) = src[e]; } }
    for (int h = 0; h < 2; ++h) {
        const int th = t0 + 128 * h;
        for (int e = tid; e < 143 * 16; e += NWAVES * 64) { const int i = e >> 4, pc = e & 15, t = th - 15 + i; v4u v = (v4u){0u, 0u, 0u, 0u};
            if (t >= 0) v = *(const GAS v4u*)(F.P + (size_t)irow_p(b, t) * DAB + g * 128 + pc * 8);
            *(LAS v4u*)(U + i * 256 + pc * 16) = v; }
        __syncthreads();
        { const int c = tid & 127, q = tid >> 7; const LAS unsigned short* Uc = (const LAS unsigned short*)U + c;
          const int i0 = 15 + 32 * q; float s = 0.f;
          for (int k = 1; k < w; ++k) s += bf2f(Uc[(i0 - k) * 128]);
          const int slot = c >> 3, sub = (c & 7) * 2;
          for (int jj = 0; jj < 32; ++jj) { const int i = i0 + jj, rl = 32 * q + jj, t = th + rl;
              const float ut = bf2f(Uc[i * 128]); s += ut;
              const float cnt = (float)(t + 1 < w ? t + 1 : w); const float d = s / cnt - ut;
              *(LAS unsigned short*)(Dt + rl * 256 + ((slot ^ (rl & 15)) << 4) + sub) = (unsigned short)f2bf(d);
              s -= bf2f(Uc[(i - w + 1) * 128]); } }
        if ((pm & 7) == 7 && h == 1) {
            for (int e = tid; e < 15 * 128; e += NWAVES * 64) { const int k = e >> 7, c = e & 127; F.out[O_POOLP + ((size_t)b * 15 + k) * 512 + g * 128 + c] = bf2f(((const LAS unsigned short*)U)[(128 + k) * 128 + c]); } }
        __syncthreads();
        f32x4 acc[8];
#pragma unroll
        for (int nb = 0; nb < 8; ++nb) acc[nb] = (f32x4){0.f, 0.f, 0.f, 0.f};
        const int rl = 16 * F.wave + fr;
#pragma unroll
        for (int kk = 0; kk < 4; ++kk) { const int sl = kk * 4 + fq;
            const bf16x8 a = *(const LAS bf16x8*)(Dt + rl * 256 + ((sl ^ (rl & 15)) << 4));
#pragma unroll
            for (int nb = 0; nb < 8; ++nb) { const int n = nb * 16 + fr; const bf16x8 bw = *(const LAS bf16x8*)(Wl + n * 256 + ((sl ^ (n & 15)) << 4));
                acc[nb] = __builtin_amdgcn_mfma_f32_16x16x32_bf16(bw, a, acc[nb], 0, 0, 0); } }
        { const int ir = irow_p(b, th + rl); bf16* op = F.A3 + (size_t)ir * D + g * 128 + 4 * fq; const float* sc = F.pool_scale + g * 128 + 4 * fq;
#pragma unroll
          for (int nb = 0; nb < 8; ++nb) { const f32x4 s4 = *(const GAS f32x4*)(sc + nb * 16); const f32x4 v = acc[nb] * s4; *(GAS v2u*)(op + nb * 16) = (v2u){pk2(v[0], v[1]), pk2(v[2], v[3])}; } }
        __syncthreads();
    }
}
__device__ __forceinline__ void conv_unit(Frame& F, int pm, int q) {
    const int b = pm >> 3, t0 = (pm & 7) * 256, oct = F.tid & 15, seg = F.tid >> 4, c = 128 * q + 8 * oct, ts = t0 + 8 * seg;
    float w0[8], w1[8], w2[8], zm2[8], zm1[8];
    { const GAS f32x4* p = (const GAS f32x4*)(F.conv_w + c); const f32x4 a0 = p[0], a1 = p[1], b0 = p[128], b1 = p[129], c0 = p[256], c1 = p[257];
#pragma unroll
      for (int i = 0; i < 4; ++i) { w0[i] = a0[i]; w0[4 + i] = a1[i]; w1[i] = b0[i]; w1[4 + i] = b1[i]; w2[i] = c0[i]; w2[4 + i] = c1[i]; } }
#pragma unroll
    for (int i = 0; i < 8; ++i) { zm2[i] = 0.f; zm1[i] = 0.f; }
    if (ts >= 2) {
        const bf16* p2 = F.P + (size_t)irow_p(b, ts - 2) * DAB + c; const bf16* p1 = F.P + (size_t)irow_p(b, ts - 1) * DAB + c;
        float xb[8], gc[8];
        unpack8(*(const GAS v4u*)(p2 + 512), xb); unpack8(*(const GAS v4u*)(p2 + 1536), gc);
#pragma unroll
        for (int i = 0; i < 8; ++i) zm2[i] = gc[i] * xb[i];
        unpack8(*(const GAS v4u*)(p1 + 512), xb); unpack8(*(const GAS v4u*)(p1 + 1536), gc);
#pragma unroll
        for (int i = 0; i < 8; ++i) zm1[i] = gc[i] * xb[i];
    }
#pragma unroll 4
    for (int r = 0; r < 8; ++r) {
        const int tt = ts + r, ir = irow_p(b, tt); const bf16* pr = F.P + (size_t)ir * DAB + c;
        float xb[8], gb[8], gc[8], z[8], y[8];
        unpack8(*(const GAS v4u*)(pr + 512), xb); unpack8(*(const GAS v4u*)(pr + 1024), gb); unpack8(*(const GAS v4u*)(pr + 1536), gc);
#pragma unroll
        for (int i = 0; i < 8; ++i) { z[i] = gc[i] * xb[i]; y[i] = gb[i] * ((w0[i] * zm2[i] + w1[i] * zm1[i]) + w2[i] * z[i]); }
        *(GAS v4u*)(F.A3 + (size_t)ir * D + 512 + c) = (v4u){pk2(y[0], y[1]), pk2(y[2], y[3]), pk2(y[4], y[5]), pk2(y[6], y[7])};
        if (tt >= SEQ - 2) { GAS f32x4* o = (GAS f32x4*)(F.out + O_CONVP + ((size_t)b * 2 + (tt - (SEQ - 2))) * 512 + c); o[0] = (f32x4){z[0], z[1], z[2], z[3]}; o[1] = (f32x4){z[4], z[5], z[6], z[7]}; }
#pragma unroll
        for (int i = 0; i < 8; ++i) { zm2[i] = zm1[i]; zm1[i] = z[i]; }
    }
}
__device__ __forceinline__ void mix0_sample_unit(Frame& F, int sm) {
    LAS unsigned char* Ds = F.lds;
    const int c = F.tid, g = c >> 7, w = 2 << g, fr = F.lane & 15, fq = F.lane >> 4;
    const float cw0 = F.conv_w[c], cw1 = F.conv_w[512 + c], cw2 = F.conv_w[1024 + c];
    const float inv = 1.f / (float)w;
    for (int i = 0; i < 2; ++i) {
        const int b = 2 * sm + i;
        float full[23];
#pragma unroll
        for (int k = 0; k < 15; ++k) full[k] = F.spool[((size_t)b * 15 + k) * 512 + c];
#pragma unroll
        for (int t = 0; t < 8; ++t) full[15 + t] = bf2f(F.P[(size_t)irow_s(b, t) * DAB + c]);
#pragma unroll
        for (int t = 0; t < 8; ++t) { float s = 0.f;
#pragma unroll
            for (int k = 15; k >= 0; --k) if (k < w) s += full[15 + t - k];
            const float d = s * inv - full[15 + t]; const int row = i * 8 + t;
            *(LAS unsigned short*)(Ds + row * 1024 + (((c >> 3) ^ row) << 4) + (c & 7) * 2) = (unsigned short)f2bf(d); }
#pragma unroll
        for (int k = 0; k < 15; ++k) F.out[O_POOLS + ((size_t)b * 15 + k) * 512 + c] = full[8 + k];
        float zm2 = F.sconv[((size_t)b * 2 + 0) * 512 + c], zm1 = F.sconv[((size_t)b * 2 + 1) * 512 + c];
#pragma unroll
        for (int t = 0; t < 8; ++t) { const int ir = irow_s(b, t); const bf16* pr = F.P + (size_t)ir * DAB + c;
            const float xb = bf2f(pr[512]), gb = bf2f(pr[1024]), gc = bf2f(pr[1536]); const float z = gc * xb;
            F.A3[(size_t)ir * D + 512 + c] = (bf16)f2bf(gb * ((cw0 * zm2 + cw1 * zm1) + cw2 * z));
            if (t >= 6) F.out[O_CONVS + ((size_t)b * 2 + (t - 6)) * 512 + c] = z;
            zm2 = zm1; zm1 = z; }
    }
    __syncthreads();
    { const int g2 = F.wave >> 1, nb0 = (F.wave & 1) * 4;
      f32x4 acc[4];
#pragma unroll
      for (int j = 0; j < 4; ++j) acc[j] = (f32x4){0.f, 0.f, 0.f, 0.f};
#pragma unroll
      for (int kk = 0; kk < 4; ++kk) { const int sl = g2 * 16 + kk * 4 + fq; const bf16x8 a = *(const LAS bf16x8*)(Ds + fr * 1024 + ((sl ^ fr) << 4));
#pragma unroll
          for (int j = 0; j < 4; ++j) { const int n = (nb0 + j) * 16 + fr; const bf16x8 bw = *(const GAS bf16x8*)(F.Wg_t + ((size_t)g2 * 128 + n) * 128 + kk * 32 + fq * 8);
              acc[j] = __builtin_amdgcn_mfma_f32_16x16x32_bf16(bw, a, acc[j], 0, 0, 0); } }
      const int ir = irow_s(2 * sm + (fr >> 3), fr & 7);
#pragma unroll
      for (int j = 0; j < 4; ++j) { const int col = g2 * 128 + (nb0 + j) * 16 + 4 * fq; const f32x4 s4 = *(const GAS f32x4*)(F.pool_scale + col); const f32x4 v = acc[j] * s4;
          *(GAS v2u*)(F.A3 + (size_t)ir * D + col) = (v2u){pk2(v[0], v[1]), pk2(v[2], v[3])}; } }
    __syncthreads();
}
__device__ __forceinline__ void mixer0_phase(Frame& F) {
    for (int u = F.vcu; u < 256; u += F.G) pool_unit(F, u >> 2, u & 3);
    for (int u = F.vcu; u < 256; u += F.G) conv_unit(F, u >> 2, u & 3);
    for (int u = F.vcu; u < 64; u += F.G) mix0_sample_unit(F, u);
}

__device__ __forceinline__ void sp_unit(Frame& F, int ck, int hh) {
    LAS float* R = (LAS float*)F.lds; LAS unsigned char* VT = F.lds + 1024;
    const int b = ck >> 4, t0 = (ck & 15) * 128, tid = F.tid, lane = F.lane, wave = F.wave, fr = lane & 15, fq = lane >> 4;
    for (int i = 0; i < 16; ++i) { const int s = 16 * wave + i; f32x4 v[4]; ld_row_bf16(F.P + (size_t)irow_p(b, t0 + s) * DAB + 1024, lane, v);
        const float ss = wave_sum(sumsq4(v)); if (lane == 0) R[s] = rsqrtf(ss * (1.f / 1024.f) + EPS); }
    __syncthreads();
    for (int hi = 0; hi < 4; ++hi) {
        const int h = 4 * hh + hi;
        for (int e = tid; e < 2048; e += NWAVES * 64) { const int s = e >> 4, d0 = (e & 15) * 8;
            float v[8]; unpack8(*(const GAS v4u*)(F.P + (size_t)irow_p(b, t0 + s) * DAB + 1024 + h * 128 + d0), v);
            const GAS f32x4* gp = (const GAS f32x4*)(F.g_v + h * 128 + d0); const f32x4 ga = gp[0], gb = gp[1]; const float rs = R[s];
            const float gv[8] = {ga[0], ga[1], ga[2], ga[3], gb[0], gb[1], gb[2], gb[3]};
#pragma unroll
            for (int i = 0; i < 8; ++i) { const int d = d0 + i; *(LAS unsigned short*)(VT + d * 256 + (((s >> 3) ^ (d & 15)) << 4) + (s & 7) * 2) = (unsigned short)f2bf((v[i] * rs) * gv[i]); } }
        __syncthreads();
        f32x4 acc[8];
#pragma unroll
        for (int nb = 0; nb < 8; ++nb) acc[nb] = (f32x4){0.f, 0.f, 0.f, 0.f};
        const int nkk = (wave >> 1) + 1;
        for (int kk = 0; kk < nkk; ++kk) { const bf16x8 wf = *(const GAS bf16x8*)(F.Wsp + ((size_t)h * 128 + 16 * wave + fr) * 128 + kk * 32 + fq * 8); const int sl = kk * 4 + fq;
#pragma unroll
            for (int nb = 0; nb < 8; ++nb) { const int d = nb * 16 + fr; const bf16x8 vf = *(const LAS bf16x8*)(VT + d * 256 + ((sl ^ (d & 15)) << 4));
                acc[nb] = __builtin_amdgcn_mfma_f32_16x16x32_bf16(vf, wf, acc[nb], 0, 0, 0); } }
        { const int t = 16 * wave + fr, ir = irow_p(b, t0 + t); const float bias = F.b_sp[h * 128 + t];
          const bf16* up = F.P + (size_t)ir * DAB + h * 128 + 4 * fq; bf16* op = F.A3 + (size_t)ir * D + h * 128 + 4 * fq;
#pragma unroll
          for (int nb = 0; nb < 8; ++nb) { const v2u uu = *(const GAS v2u*)(up + nb * 16); const f32x4 a = acc[nb];
              *(GAS v2u*)(op + nb * 16) = (v2u){pk2(bflo(uu.x) * (a[0] + bias), bfhi(uu.x) * (a[1] + bias)), pk2(bflo(uu.y) * (a[2] + bias), bfhi(uu.y) * (a[3] + bias))}; } }
        __syncthreads();
    }
}
__device__ __forceinline__ void sp_sample_unit(Frame& F, int sm) {
    LAS float* VN = (LAS float*)F.lds;
    const int tid = F.tid, lane = F.lane, wave = F.wave;
    f32x4 GV[4]; ld_row_f32(F.g_v, lane, GV);
    for (int i = 0; i < 2; ++i) { const int row = 2 * wave + i, b = 2 * sm + (row >> 3), t = row & 7;
        f32x4 v[4]; ld_row_bf16(F.P + (size_t)irow_s(b, t) * DAB + 1024, lane, v);
        const float rs = rsqrtf(wave_sum(sumsq4(v)) * (1.f / 1024.f) + EPS);
#pragma unroll
        for (int j = 0; j < 4; ++j) v[j] = (v[j] * rs) * GV[j];
        st_row_f32(F.out + O_V + ((size_t)b * 8 + t) * 1024, lane, v);
        LAS f32x4* p = (LAS f32x4*)(VN + row * 1024) + 2 * lane; p[0] = v[0]; p[1] = v[1]; p[128] = v[2]; p[129] = v[3]; }
    __syncthreads();
    for (int cc = 0; cc < 2; ++cc) { const int c = tid + 512 * cc, h = c >> 7;
        for (int i = 0; i < 2; ++i) { const int b = 2 * sm + i; float vn[8];
#pragma unroll
            for (int s = 0; s < 8; ++s) vn[s] = VN[(i * 8 + s) * 1024 + c];
#pragma unroll
            for (int t = 0; t < 8; ++t) { float o = F.b_sp[h * 128 + t];
#pragma unroll
                for (int s = 0; s <= t; ++s) o += F.w_sp[((size_t)h * 128 + t) * 128 + s] * vn[s];
                const int ir = irow_s(b, t); F.A3[(size_t)ir * D + c] = (bf16)f2bf(bf2f(F.P[(size_t)ir * DAB + c]) * o); } } }
    __syncthreads();
}
__device__ __forceinline__ void mixer1_phase(Frame& F) {
    for (int u = F.vcu; u < 256; u += F.G) sp_unit(F, u >> 1, u & 1);
    for (int u = F.vcu; u < 64; u += F.G) sp_sample_unit(F, u);
}

struct Args { const float* in[20]; float* out; unsigned char* ws; };
__global__ void __launch_bounds__(NWAVES * 64, 2) fwd_megakernel(Args args) {
    extern __shared__ __attribute__((aligned(16))) unsigned char lds[];
    Frame F;
    F.lds = (LAS unsigned char*)lds;
    F.MISC = (volatile LAS unsigned*)(F.lds + MISC_OFF);
    F.tid = threadIdx.x; F.lane = F.tid & 63; F.wave = __builtin_amdgcn_readfirstlane(F.tid >> 6);
    F.G = gridDim.x; { const int bx = blockIdx.x; F.vcu = (F.G % 8 == 0) ? (bx % 8) * (F.G / 8) + bx / 8 : bx; }
    unsigned char* ws = args.ws;
    F.ctl = (gu32*)(ws + WS_CTL);
    F.xp = args.in[0]; F.xs = args.in[1]; F.spool = args.in[2]; F.sconv = args.in[3]; F.g_mix_pre = args.in[4]; F.g_mix_post = args.in[5]; F.g_ffn_pre = args.in[6]; F.g_ffn_post = args.in[7];
    F.w_in = args.in[8]; F.w_grp = args.in[9]; F.pool_scale = args.in[10]; F.conv_w = args.in[11]; F.w_oab = args.in[12]; F.w_uv = args.in[13]; F.g_v = args.in[14]; F.w_sp = args.in[15]; F.b_sp = args.in[16];
    F.w_oc = args.in[17]; F.w_up = args.in[18]; F.w_dn = args.in[19]; F.out = args.out;
    F.Win_t = (bf16*)(ws + WS_WIN); F.Woab_t = (bf16*)(ws + WS_WOAB); F.Wuv_t = (bf16*)(ws + WS_WUV); F.Woc_t = (bf16*)(ws + WS_WOC); F.Wup_t = (bf16*)(ws + WS_WUP); F.Wdn_t = (bf16*)(ws + WS_WDN);
    F.Wg_t = (bf16*)(ws + WS_WGRP); F.Wsp = (bf16*)(ws + WS_WSP);
    F.XN = (bf16*)(ws + WS_XN); F.P = (bf16*)(ws + WS_P); F.A3 = (bf16*)(ws + WS_A3); F.MF = (bf16*)(ws + WS_MF); F.MF2 = (bf16*)(ws + WS_MF2); F.H = (bf16*)(ws + WS_H);
    for (int u = F.tid; u < (LDS_BYTES - LDSCTL_OFF) / 4; u += NWAVES * 64) ((LAS unsigned*)(F.lds + LDSCTL_OFF))[u] = 0u;
    __syncthreads();
    XcdBarrier bar = xcd_barrier_post((unsigned*)(F.ctl + CW_BAR), F.MISC + 8);
#define GRID_BAR() xcd_barrier(bar)

    p0_prologue(F); GRID_BAR();
    for (int st = 0; st < 14; ++st) {
        const int l = st / 7, s = st % 7;
        { int tv = threadIdx.x; asm volatile("" : "+v"(tv)); F.tid = tv; F.lane = tv & 63; F.wave = __builtin_amdgcn_readfirstlane(tv >> 6); }
        if (s == 0 || s == 2 || s == 4 || s == 5) {
            const bf16* A; const bf16* Bt; bf16* O; int N, K, act = 0;
            if (s == 0) { A = F.XN; Bt = l ? F.Wuv_t : F.Win_t; N = DAB; K = D; O = F.P; }
            else if (s == 2) { A = F.A3; Bt = l ? F.Woc_t : F.Woab_t; N = D; K = D; O = F.MF; }
            else if (s == 4) { A = F.XN; Bt = F.Wup_t + (size_t)l * D * FF; N = FF; K = D; O = F.H; act = 1; }
            else { A = F.H; Bt = F.Wdn_t + (size_t)l * D * FF; N = D; K = FF; O = F.MF2; }
            pg8::Gemm g{A, Bt, M, N, K}; pg8::StaticOrder S; S.init(M, N, F.G, (int)blockIdx.x);
            pg8::EpiBf16 E{O, N, act};
            pg8::gemm_phase<pg8::EpiBf16, pg8::StaticOrder, PG8_ALIGN, PG8_SP2>(F.lds + RING_OFF, g, S, E, F.tid);
        } else if (s == 1) {
            if (l == 0) mixer0_phase(F); else mixer1_phase(F);
        } else {
            const bool first = (st == 3), last = (st == 13);
            norm_phase(F, s == 3 ? F.MF : F.MF2, (s == 3 ? F.g_mix_post : F.g_ffn_post) + l * D, s == 3 ? F.g_ffn_pre + l * D : F.g_mix_pre + D, first, last);
        }
        if (st != 13) GRID_BAR();
    }
}

extern "C" void kernel_launch(void* const* d_in, const int* in_sizes, int n_in, void* d_out, int out_size, void* d_ws, size_t ws_size, hipStream_t stream) {
    static int grid = 0;
    if (grid == 0) {
        if (n_in != 20 || in_sizes[0] != MP * D || (size_t)out_size != O_END || ws_size < WS_END) { fprintf(stderr, "kernel_launch: unexpected shapes (n_in %d, in0 %d, out %d, ws %zu); nothing launched\n", n_in, n_in > 0 ? in_sizes[0] : -1, out_size, ws_size); grid = -1; return; }
        int dev = 0, cus = 0, per_cu = 0;
        if (hipGetDevice(&dev) != hipSuccess || hipDeviceGetAttribute(&cus, hipDeviceAttributeMultiprocessorCount, dev) != hipSuccess) { fprintf(stderr, "kernel_launch: hipGetDevice / hipDeviceGetAttribute failed\n"); grid = -1; return; }
        if (hipFuncSetAttribute((const void*)fwd_megakernel, hipFuncAttributeMaxDynamicSharedMemorySize, LDS_BYTES) != hipSuccess) { fprintf(stderr, "kernel_launch: hipFuncSetAttribute failed\n"); grid = -1; return; }
        if (hipOccupancyMaxActiveBlocksPerMultiprocessor(&per_cu, (const void*)fwd_megakernel, NWAVES * 64, LDS_BYTES) != hipSuccess || per_cu < 1)
            fprintf(stderr, "kernel_launch: note: occupancy query reports %d workgroups per CU\n", per_cu);
        (void)hipGetLastError();
        grid = cus;
    }
    if (grid < 0) return;
    if (hipMemsetAsync((char*)d_ws + WS_CTL, 0, CTL_ZERO_BYTES, stream) != hipSuccess) { fprintf(stderr, "kernel_launch: hipMemsetAsync failed\n"); return; }
    Args a{};
    for (int i = 0; i < 20; ++i) a.in[i] = (const float*)d_in[i];
    a.out = (float*)d_out; a.ws = (unsigned char*)d_ws;
    hipLaunchKernelGGL(fwd_megakernel, dim3(grid), dim3(NWAVES * 64), LDS_BYTES, stream, a);
    const hipError_t le = hipPeekAtLastError();
    if (le != hipSuccess) fprintf(stderr, "kernel_launch: launch failed: %s\n", hipGetErrorName(le));
}
```

```cpp
#include <hip/hip_runtime.h>
#include <cstdio>
#include <cstdint>
namespace pg8 {
#define PG8_LAS __attribute__((address_space(3)))
typedef unsigned short bf16_t;
typedef short bf16x8 __attribute__((ext_vector_type(8)));
typedef float f32x4 __attribute__((ext_vector_type(4)));
typedef unsigned u32x4 __attribute__((ext_vector_type(4)));
typedef unsigned u32x2 __attribute__((ext_vector_type(2)));
constexpr int BM = 256, PROWS = 272, BK = 64, HALF = 128, HTB = HALF * BK * 2  , XTB = 16 * BK * 2  , STAGE_BYTES = 8 * HTB + 2 * XTB, NXCD = 8, WGM = 8;

__host__ __device__ __forceinline__ int lds_byte(int r, int c) { const int st = (r >> 4) * 2 + (c >> 5), rr = r & 15, cc = c & 31, ob = rr * 64 + cc * 2; return st * 1024 + (ob ^ (((ob >> 9) & 1) << 5)); }
__host__ __device__ __forceinline__ void stage_rc(int b, int& R, int& C) { const int st = b / 1024, sb = b % 1024, swz = sb ^ (((sb >> 9) & 1) << 5); R = (st >> 1) * 16 + swz / 64; C = (st & 1) * 32 + (swz % 64) / 2; }
__host__ __device__ __forceinline__ int perm32(int rho) { const int n = rho >> 4, i = rho & 15; return 8 * (i >> 2) + 4 * n + (i & 3); }

struct Unit { int pm, pn; };
struct Gemm { const bf16_t* A; const bf16_t* Bt; int nM, N, K; };

struct StaticOrder {
    int nM, nN, nwg, G, c;
    __host__ __device__ void init(int nM_, int N, int G_, int c_) { nM = nM_; nN = N / BM; nwg = nM * nN; G = G_; c = c_; }
    __host__ __device__ bool next(int i, Unit& u) const {
        const long L = (long)i * G + c; if (L >= nwg) return false;
        int wgid = (int)L; { const int q = nwg / NXCD, r = nwg % NXCD, xcd = wgid % NXCD, off = wgid / NXCD; wgid = (xcd < r ? xcd * (q + 1) : r * (q + 1) + (xcd - r) * q) + off; }
        const int nig = WGM * nN, gid = wgid / nig, fm = gid * WGM, gsz = (nM - fm) < WGM ? (nM - fm) : WGM;
        u.pm = fm + ((wgid % nig) % gsz); u.pn = (wgid % nig) / gsz; return true;
    }
    __device__ __forceinline__ void a_ready(const Unit&) const {}
    __device__ __forceinline__ void done(const Unit&) const {}
};

__device__ __forceinline__ unsigned cvt_pk_bf16(float lo, float hi) { unsigned r; asm volatile("v_cvt_pk_bf16_f32 %0, %1, %2" : "=v"(r) : "v"(lo), "v"(hi)); return r; }

struct EpiBf16 {
    static constexpr bool PERM = true, AFTER_DRAIN = false;
    bf16_t* O; int ldc; int act;
    __device__ __forceinline__ u32x4 pack(f32x4 v0, f32x4 v1) const {
        if (act) {
#pragma unroll
            for (int j = 0; j < 4; ++j) { const float a = fmaxf(v0[j], 0.f), b = fmaxf(v1[j], 0.f); v0[j] = a * a; v1[j] = b * b; } }
        u32x4 w; w.x = cvt_pk_bf16(v0[0], v0[1]); w.y = cvt_pk_bf16(v0[2], v0[3]); w.z = cvt_pk_bf16(v1[0], v1[1]); w.w = cvt_pk_bf16(v1[2], v1[3]); return w; }
    __device__ __forceinline__ void operator()(const f32x4 (&acc)[2][2][4][2], const f32x4 (&acc2)[2], const Unit& u, int wr, int wc, int fr, int fq) const {
        const int row0 = u.pm * PROWS + wr * 64 + fr; const int col0 = u.pn * BM + wc * 32 + 8 * fq;
#pragma unroll
        for (int ai = 0; ai < 2; ++ai)
#pragma unroll
            for (int m = 0; m < 4; ++m) { bf16_t* rowp = O + (size_t)(row0 + ai * HALF + m * 16) * ldc + col0;
#pragma unroll
                for (int bj = 0; bj < 2; ++bj) *(u32x4*)(rowp + bj * HALF) = pack(acc[ai][bj][m][0], acc[ai][bj][m][1]); }
        *(u32x4*)(O + (size_t)(u.pm * PROWS + BM + fr) * ldc + col0 + wr * HALF) = pack(acc2[0], acc2[1]);
    }
};

template <class Epi, class Sched, bool ALIGN_EPI>
__device__ __forceinline__ void gemm_phase(PG8_LAS unsigned char* lds, const Gemm g, const Sched& S, const Epi& E, const int tid) {
    const int wid = __builtin_amdgcn_readfirstlane(tid >> 6), lane = tid & 63, wr = wid >> 2, wc = wid & 3, fr = lane & 15, fq = lane >> 4;
    const int K = g.K, nt = K / BK;
    unsigned voffA[2], voffB[2], voffX;
#pragma unroll
    for (int i = 0; i < 2; ++i) { int R, C; stage_rc(tid * 16 + i * 8192, R, C); const int Rb = Epi::PERM ? ((R & ~31) + perm32(R & 31)) : R;
        voffA[i] = (unsigned)(R * K + C) * 2u; voffB[i] = (unsigned)(Rb * K + C) * 2u; }
    { int R, C; stage_rc((wid & 1) * 1024 + lane * 16, R, C); voffX = (unsigned)(R * K + C) * 2u; }
    const size_t kstep = (size_t)(BK * 2);
    const size_t hstep = (size_t)HALF * K * 2;
    const size_t xstep = 2 * hstep;
    const size_t tstepA = (size_t)PROWS * K * 2, tstepB = 2 * hstep;
    const unsigned ldsw = (unsigned)wid * 1024u;
    const unsigned ldsx = (unsigned)(wid & 1) * 1024u;
    const int aoff = lds_byte(wr * 64 + fr, fq * 8), boff = lds_byte(wc * 32 + fr, fq * 8), xoff = lds_byte(fr, fq * 8);
#define PG8_SA(b, h) (((b) * 2 + (h)) * HTB)
#define PG8_SB(b, h) ((4 + (b) * 2 + (h)) * HTB)
#define PG8_XA(b) (8 * HTB + (b) * XTB)
#define PG8_STAGE(bufoff, gbase, voff) do { _Pragma("unroll") for (int _i = 0; _i < 2; ++_i) \
        __builtin_amdgcn_global_load_lds((const unsigned*)((const char*)(gbase) + (voff)[_i]), (PG8_LAS unsigned*)(lds + (bufoff) + ldsw + _i * 8192), 16, 0, 0); } while (0)
#define PG8_STAGE_X(bufoff, gbase) __builtin_amdgcn_global_load_lds((const unsigned*)((const char*)(gbase) + voffX), (PG8_LAS unsigned*)(lds + (bufoff) + ldsx), 16, 0, 0)
#define PG8_LDA(dst, b, h) do { _Pragma("unroll") for (int m = 0; m < 4; ++m) _Pragma("unroll") for (int k = 0; k < 2; ++k) dst[m][k] = *(const PG8_LAS bf16x8*)(lds + PG8_SA(b, h) + aoff + m * 2048 + k * 1024); } while (0)
#define PG8_LDB(dst, b, h) do { _Pragma("unroll") for (int n = 0; n < 2; ++n) _Pragma("unroll") for (int k = 0; k < 2; ++k) dst[n][k] = *(const PG8_LAS bf16x8*)(lds + PG8_SB(b, h) + boff + n * 2048 + k * 1024); } while (0)
#define PG8_LDX(dst, b) do { _Pragma("unroll") for (int k = 0; k < 2; ++k) dst[k] = *(const PG8_LAS bf16x8*)(lds + PG8_XA(b) + xoff + k * 1024); } while (0)
#define PG8_MMA(ai, bj, At, Bt) do { __builtin_amdgcn_s_setprio(1); _Pragma("unroll") for (int m = 0; m < 4; ++m) _Pragma("unroll") for (int n = 0; n < 2; ++n) _Pragma("unroll") for (int k = 0; k < 2; ++k) \
        acc[ai][bj][m][n] = __builtin_amdgcn_mfma_f32_16x16x32_bf16(Bt[n][k], At[m][k], acc[ai][bj][m][n], 0, 0, 0); __builtin_amdgcn_s_setprio(0); } while (0)
#define PG8_MMAX(Xf) do { __builtin_amdgcn_s_setprio(1); \
        if (wr == 0) { _Pragma("unroll") for (int n = 0; n < 2; ++n) _Pragma("unroll") for (int k = 0; k < 2; ++k) acc2[n] = __builtin_amdgcn_mfma_f32_16x16x32_bf16(B0[n][k], Xf[k], acc2[n], 0, 0, 0); } \
        else         { _Pragma("unroll") for (int n = 0; n < 2; ++n) _Pragma("unroll") for (int k = 0; k < 2; ++k) acc2[n] = __builtin_amdgcn_mfma_f32_16x16x32_bf16(B1[n][k], Xf[k], acc2[n], 0, 0, 0); } \
        __builtin_amdgcn_s_setprio(0); } while (0)
#define PG8_WAIT_V(n) asm volatile("s_waitcnt vmcnt(" #n ")" ::: "memory")
#define PG8_WAIT_L(n) asm volatile("s_waitcnt lgkmcnt(" #n ")" ::: "memory")
#define PG8_BAR __builtin_amdgcn_s_barrier()
#define PG8_SCHED __builtin_amdgcn_sched_barrier(0)
    Unit cur, nxt; int ui = 0;
    if (!S.next(0, cur)) return;
    f32x4 acc[2][2][4][2]; f32x4 acc2[2];
#pragma unroll
    for (int a = 0; a < 2; ++a)
#pragma unroll
        for (int b = 0; b < 2; ++b)
#pragma unroll
            for (int m = 0; m < 4; ++m)
#pragma unroll
                for (int n = 0; n < 2; ++n) acc[a][b][m][n] = (f32x4){0.f, 0.f, 0.f, 0.f};
    acc2[0] = (f32x4){0.f, 0.f, 0.f, 0.f}; acc2[1] = (f32x4){0.f, 0.f, 0.f, 0.f};
    bf16x8 At[4][2], B0[2][2], B1[2][2], Xf[2];
    const char* cA = (const char*)g.A + (size_t)cur.pm * tstepA; const char* cB = (const char*)g.Bt + (size_t)cur.pn * tstepB;
    S.a_ready(cur);
    PG8_STAGE(PG8_SB(0, 0), cB, voffB); PG8_STAGE(PG8_SB(0, 1), cB + hstep, voffB); PG8_STAGE(PG8_SA(0, 0), cA, voffA); PG8_STAGE(PG8_SA(0, 1), cA + hstep, voffA); PG8_STAGE_X(PG8_XA(0), cA + xstep);
    if (wr == 1) PG8_BAR;
    PG8_WAIT_V(3); PG8_BAR;
    PG8_STAGE(PG8_SB(1, 0), cB + kstep, voffB); PG8_STAGE(PG8_SA(1, 0), cA + kstep, voffA); PG8_STAGE(PG8_SB(1, 1), cB + hstep + kstep, voffB);
    PG8_WAIT_V(6); PG8_BAR;
    for (;;) {
        const bool has_next = S.next(ui + 1, nxt);
        const char* nA = has_next ? (const char*)g.A + (size_t)nxt.pm * tstepA : cA; const char* nB = has_next ? (const char*)g.Bt + (size_t)nxt.pn * tstepB : cB;
        for (int t = 0; t < nt; t += 2) {
            const bool last = (t == nt - 2);
            const char* a1 = cA + (size_t)(t + 1) * kstep;
            const char* a2 = last ? nA : cA + (size_t)(t + 2) * kstep; const char* b2 = last ? nB : cB + (size_t)(t + 2) * kstep;
            const char* a3 = a2 + kstep; const char* b3 = b2 + kstep;
            if (last && has_next) S.a_ready(nxt);
            PG8_LDB(B0, 0, 0); PG8_LDB(B1, 0, 1); PG8_SCHED; PG8_LDA(At, 0, 0); PG8_STAGE(PG8_SA(1, 1), a1 + hstep, voffA); PG8_STAGE_X(PG8_XA(1), a1 + xstep);
            PG8_WAIT_V(9); PG8_WAIT_L(0); PG8_BAR; PG8_MMA(0, 0, At, B0); PG8_MMA(0, 1, At, B1); PG8_BAR; PG8_SCHED;
            PG8_LDA(At, 0, 1); PG8_LDX(Xf, 0); PG8_STAGE(PG8_SB(0, 0), b2, voffB); PG8_STAGE(PG8_SB(0, 1), b2 + hstep, voffB); PG8_STAGE(PG8_SA(0, 0), a2, voffA);
            PG8_WAIT_V(9); PG8_WAIT_L(0); PG8_BAR; PG8_MMA(1, 0, At, B0); PG8_MMA(1, 1, At, B1); PG8_MMAX(Xf); PG8_BAR; PG8_SCHED;
            PG8_LDB(B0, 1, 0); PG8_LDB(B1, 1, 1); PG8_SCHED; PG8_LDA(At, 1, 0); PG8_STAGE(PG8_SA(0, 1), a2 + hstep, voffA); PG8_STAGE_X(PG8_XA(0), a2 + xstep);
            PG8_WAIT_V(9); PG8_WAIT_L(0); PG8_BAR; PG8_MMA(0, 0, At, B0); PG8_MMA(0, 1, At, B1); PG8_BAR; PG8_SCHED;
            PG8_LDA(At, 1, 1); PG8_LDX(Xf, 1); PG8_STAGE(PG8_SB(1, 0), b3, voffB); PG8_STAGE(PG8_SB(1, 1), b3 + hstep, voffB); PG8_STAGE(PG8_SA(1, 0), a3, voffA);
            PG8_WAIT_V(9); PG8_WAIT_L(0); PG8_BAR; PG8_MMA(1, 0, At, B0); PG8_MMA(1, 1, At, B1); PG8_MMAX(Xf); PG8_BAR; PG8_SCHED;
        }
        if constexpr (ALIGN_EPI) { if (wr == 0) PG8_BAR; }
        if constexpr (!Epi::AFTER_DRAIN) { E(acc, acc2, cur, wr, wc, fr, fq); S.done(cur); }
        if (!has_next) break;
#pragma unroll
        for (int a = 0; a < 2; ++a)
#pragma unroll
            for (int b = 0; b < 2; ++b)
#pragma unroll
                for (int m = 0; m < 4; ++m)
#pragma unroll
                    for (int n = 0; n < 2; ++n) acc[a][b][m][n] = (f32x4){0.f, 0.f, 0.f, 0.f};
        acc2[0] = (f32x4){0.f, 0.f, 0.f, 0.f}; acc2[1] = (f32x4){0.f, 0.f, 0.f, 0.f};
        cur = nxt; cA = nA; cB = nB; ++ui;
        if constexpr (ALIGN_EPI) { if (wr == 1) PG8_BAR; }
    }
    PG8_WAIT_V(0);
    if constexpr (!ALIGN_EPI) { if (wr == 0) PG8_BAR; }
    PG8_BAR;
    if constexpr (Epi::AFTER_DRAIN) { E.fused(acc, acc2, cur, wr, wc, fr, fq, lds, wid, lane); S.done(cur); }
#undef PG8_SA
#undef PG8_SB
#undef PG8_XA
#undef PG8_STAGE
#undef PG8_STAGE_X
#undef PG8_LDA
#undef PG8_LDB
#undef PG8_LDX
#undef PG8_MMA
#undef PG8_MMAX
#undef PG8_WAIT_V
#undef PG8_WAIT_L
#undef PG8_BAR
#undef PG8_SCHED
}
}

#ifndef PG8_SP2
#define PG8_SP2 true
#endif
#ifndef PG8_ALIGN
#define PG8_ALIGN true
#endif
constexpr int NWAVES = 8;

constexpr int D = 1024, NB = 8, SEQ = 2048, NSB = 128, SSEQ = 8;
constexpr int MP = NB * SEQ, MS = NSB * SSEQ, M = MP + MS;
constexpr int DAB = 2048, FF = 4096;
constexpr float EPS = 1e-6f;
constexpr size_t O_POOLP = (size_t)M * D, O_POOLS = O_POOLP + 8 * 15 * 512, O_CONVP = O_POOLS + 128 * 15 * 512, O_CONVS = O_CONVP + 8 * 2 * 512, O_V = O_CONVS + 128 * 2 * 512, O_END = O_V + 128 * 8 * 1024;

constexpr size_t MiB = 1u << 20;
constexpr size_t WS_CTL = 0, CTL_ZERO_BYTES = 1 * MiB;
constexpr size_t WS_WIN = 2 * MiB, WS_WOAB = 6 * MiB, WS_WUV = 8 * MiB, WS_WOC = 12 * MiB, WS_WUP = 14 * MiB, WS_WDN = 30 * MiB;
constexpr size_t WS_WGRP = 46 * MiB, WS_WSP = 46 * MiB + 128 * 1024;
constexpr size_t WS_XN = 47 * MiB;
constexpr size_t WS_MF2 = 81 * MiB;
constexpr size_t WS_H = 115 * MiB;
constexpr size_t WS_P = 115 * MiB, WS_A3 = 183 * MiB, WS_MF = 217 * MiB, WS_END = 251 * MiB;
static_assert(WS_H + (size_t)M * FF * 2 == WS_END && WS_P + (size_t)M * DAB * 2 == WS_A3 && WS_A3 + (size_t)M * D * 2 == WS_MF && WS_MF + (size_t)M * D * 2 == WS_END && WS_XN + (size_t)M * D * 2 == WS_MF2 && WS_MF2 + (size_t)M * D * 2 == WS_H, "d_ws map");
constexpr int CW_TMO = 0, CW_CODE = 1, CW_BAR = 4096;

constexpr int RING_OFF = 0, RING_BYTES = pg8::STAGE_BYTES;
constexpr int LDSCTL_OFF = RING_BYTES, MISC_OFF = LDSCTL_OFF + 320;
constexpr int LDS_BYTES = 147456;

#define GAS __attribute__((address_space(1)))
#define LAS __attribute__((address_space(3)))
typedef unsigned short bf16;
typedef unsigned v4u __attribute__((ext_vector_type(4)));
typedef unsigned v2u __attribute__((ext_vector_type(2)));
typedef float f32x4 __attribute__((ext_vector_type(4)));
typedef short bf16x8 __attribute__((ext_vector_type(8)));
typedef GAS unsigned gu32;
#define RLX_AGENT __ATOMIC_RELAXED, __HIP_MEMORY_SCOPE_AGENT
#define LDS_WAIT() asm volatile("s_waitcnt lgkmcnt(0)" ::: "memory")
#define VM_WAIT() asm volatile("s_waitcnt vmcnt(0)" ::: "memory")
__device__ __forceinline__ unsigned f2bf(float f) { unsigned u = __builtin_bit_cast(unsigned, f); return (u + 0x7fffu + ((u >> 16) & 1u)) >> 16; }
__device__ __forceinline__ unsigned pk2(float lo, float hi) { return pg8::cvt_pk_bf16(lo, hi); }
__device__ __forceinline__ float bf2f(unsigned short h) { return __uint_as_float((unsigned)h << 16); }
__device__ __forceinline__ float bflo(unsigned w) { return __uint_as_float(w << 16); }
__device__ __forceinline__ float bfhi(unsigned w) { return __uint_as_float(w & 0xffff0000u); }
__device__ __forceinline__ void unpack8(const v4u a, float (&v)[8]) { v[0] = bflo(a.x); v[1] = bfhi(a.x); v[2] = bflo(a.y); v[3] = bfhi(a.y); v[4] = bflo(a.z); v[5] = bfhi(a.z); v[6] = bflo(a.w); v[7] = bfhi(a.w); }

__device__ __forceinline__ int irow_p(int b, int t) { return 272 * (b * 8 + (t >> 8)) + (t & 255); }
__device__ __forceinline__ int irow_s(int b, int t) { return 272 * (b >> 1) + 256 + (b & 1) * 8 + t; }
__device__ __forceinline__ int nat_row(int r) { const int p = r / 272, j = r - p * 272; return j < 256 ? 256 * p + j : MP + 16 * p + (j - 256); }

#define XB_TMO      128
#define XB_XCNT(j)  (256  + 64 * (j))
#define XB_XSUB(j)  (1280 + 64 * (j))
#define XB_XGEN(j)  (2304 + 64 * (j))
#define XB_TOP      3328
#define XB_TOPGEN   3392
#define XCD_BAR_WORDS 3456
#define XB_SPIN_CAP (1u << 18)

__device__ __forceinline__ unsigned xb_ld(unsigned* p)              { return __hip_atomic_load(p, __ATOMIC_RELAXED, __HIP_MEMORY_SCOPE_AGENT); }
__device__ __forceinline__ unsigned xb_add(unsigned* p, unsigned v) { return __hip_atomic_fetch_add(p, v, __ATOMIC_RELAXED, __HIP_MEMORY_SCOPE_AGENT); }
__device__ __forceinline__ unsigned xb_xcc_id() { return (unsigned)__builtin_amdgcn_s_getreg((3 << 11) | 20) & 0xFu; }
#define XB_SPIN(cond, bar) do { unsigned _sp = 0; while (cond) { __builtin_amdgcn_s_sleep(1); \
    if ((++_sp & 255u) == 0u) { if (xb_ld(&(bar)[XB_TMO])) break; if (_sp > XB_SPIN_CAP) { atomicAdd(&(bar)[XB_TMO], 1u); break; } } } } while (0)

struct XcdBarrier {
    unsigned* bar; unsigned x;
    volatile LAS unsigned* st;
};

__device__ __forceinline__ XcdBarrier xcd_barrier_post(unsigned* bar, volatile LAS unsigned* st) {
    XcdBarrier b; b.bar = bar; b.x = xb_xcc_id(); b.st = st;
    if (threadIdx.x == 0) (void)xb_add(&bar[XB_XCNT(b.x)], 1u);
    return b;
}
__device__ __forceinline__ void xcd_barrier_complete(unsigned* bar, unsigned x, unsigned& nloc, unsigned& nx) {
    const unsigned G = gridDim.x * gridDim.y * gridDim.z;
    unsigned sum, cnt, mine, sp = 0u;
    for (;;) {
        sum = 0u; cnt = 0u; mine = 0u;
#pragma unroll
        for (unsigned j = 0; j < 16; ++j) { const unsigned c = xb_ld(&bar[XB_XCNT(j)]); sum += c; cnt += (c > 0u) ? 1u : 0u; mine = (j == x) ? c : mine; }
        if (sum == G) break;
        __builtin_amdgcn_s_sleep(1);
        if ((++sp & 255u) == 0u) { if (xb_ld(&bar[XB_TMO])) break; if (sp > XB_SPIN_CAP) { atomicAdd(&bar[XB_TMO], 1u); break; } }
    }
    nloc = mine > 0u ? mine : 1u; nx = cnt > 0u ? cnt : 1u;
}

__device__ __forceinline__ void xcd_barrier(const XcdBarrier& b) {
    asm volatile("s_waitcnt vmcnt(0)" ::: "memory");
    __syncthreads();
    if (threadIdx.x == 0) {
        unsigned* bar = b.bar;
        __builtin_amdgcn_s_waitcnt(0);
        const unsigned bx_ = xb_xcc_id();
        unsigned nloc = b.st[0], nx = b.st[1];
        if (nloc == 0u) { xcd_barrier_complete(bar, bx_, nloc, nx); b.st[0] = nloc; b.st[1] = nx; }
        const unsigned old = xb_add(&bar[XB_XSUB(bx_)], 1u);
        const unsigned gen = old / nloc;
        if (old + 1u == (gen + 1u) * nloc) {
            __builtin_amdgcn_fence(__ATOMIC_RELEASE, "agent");
            asm volatile("s_waitcnt vmcnt(0)" ::: "memory");
            const unsigned og = xb_add(&bar[XB_TOP], 1u);
            const unsigned tg = og / nx;
            if (og + 1u == (tg + 1u) * nx) xb_add(&bar[XB_TOPGEN], 1u);
            else XB_SPIN(xb_ld(&bar[XB_TOPGEN]) == tg, bar);
            __builtin_amdgcn_fence(__ATOMIC_ACQUIRE, "agent");
            xb_add(&bar[XB_XGEN(bx_)], 1u);
            asm volatile("s_waitcnt vmcnt(0)" ::: "memory");
        } else {
            XB_SPIN(xb_ld(&bar[XB_XGEN(bx_)]) == gen, bar);
            __builtin_amdgcn_fence(__ATOMIC_ACQUIRE, "agent");
            asm volatile("s_waitcnt vmcnt(0)" ::: "memory");
        }
    }
    __syncthreads();
}

struct Frame {
    LAS unsigned char* lds;
    volatile LAS unsigned* MISC;
    gu32* ctl;
    int tid, lane, wave;
    int vcu, G;
    const float *xp, *xs, *spool, *sconv, *g_mix_pre, *g_mix_post, *g_ffn_pre, *g_ffn_post, *w_in, *w_grp, *pool_scale, *conv_w, *w_oab, *w_uv, *g_v, *w_sp, *b_sp, *w_oc, *w_up, *w_dn;
    float* out;
    bf16 *Win_t, *Woab_t, *Wuv_t, *Woc_t, *Wup_t, *Wdn_t, *Wg_t, *Wsp;
    bf16 *XN, *P, *A3, *MF, *MF2, *H;
};

__device__ __forceinline__ float wave_sum(float v) {
#define WS_SWZ(o) v += __uint_as_float((unsigned)__builtin_amdgcn_ds_swizzle((int)__float_as_uint(v), ((o) << 10) | 0x1f))
    WS_SWZ(1); WS_SWZ(2); WS_SWZ(4); WS_SWZ(8); WS_SWZ(16);
#undef WS_SWZ
    return __uint_as_float((unsigned)__builtin_amdgcn_readlane((int)__float_as_uint(v), 0)) + __uint_as_float((unsigned)__builtin_amdgcn_readlane((int)__float_as_uint(v), 32));
}
__device__ __forceinline__ void ld_row_f32(const float* row, int lane, f32x4 (&v)[4]) { const GAS f32x4* p = (const GAS f32x4*)row + 2 * lane; v[0] = p[0]; v[1] = p[1]; v[2] = p[128]; v[3] = p[129]; }
__device__ __forceinline__ void st_row_f32(float* row, int lane, const f32x4 (&v)[4]) { GAS f32x4* p = (GAS f32x4*)row + 2 * lane; p[0] = v[0]; p[1] = v[1]; p[128] = v[2]; p[129] = v[3]; }
__device__ __forceinline__ void ld_row_bf16(const bf16* row, int lane, f32x4 (&v)[4]) {
    const GAS v4u* p = (const GAS v4u*)row + lane; const v4u a = p[0], b = p[64];
    v[0] = (f32x4){bflo(a.x), bfhi(a.x), bflo(a.y), bfhi(a.y)}; v[1] = (f32x4){bflo(a.z), bfhi(a.z), bflo(a.w), bfhi(a.w)};
    v[2] = (f32x4){bflo(b.x), bfhi(b.x), bflo(b.y), bfhi(b.y)}; v[3] = (f32x4){bflo(b.z), bfhi(b.z), bflo(b.w), bfhi(b.w)};
}
__device__ __forceinline__ void st_row_bf16(bf16* row, int lane, const f32x4 (&v)[4]) {
    GAS v4u* p = (GAS v4u*)row + lane;
    p[0] = (v4u){pk2(v[0][0], v[0][1]), pk2(v[0][2], v[0][3]), pk2(v[1][0], v[1][1]), pk2(v[1][2], v[1][3])};
    p[64] = (v4u){pk2(v[2][0], v[2][1]), pk2(v[2][2], v[2][3]), pk2(v[3][0], v[3][1]), pk2(v[3][2], v[3][3])};
}
__device__ __forceinline__ float sumsq4(const f32x4 (&v)[4]) { float s = 0.f;
#pragma unroll
    for (int j = 0; j < 4; ++j) s += (v[j][0] * v[j][0] + v[j][1] * v[j][1]) + (v[j][2] * v[j][2] + v[j][3] * v[j][3]);
    return s; }
__device__ __forceinline__ const float* x_row(const Frame& F, int n) { return n < MP ? F.xp + (size_t)n * D : F.xs + (size_t)(n - MP) * D; }

__device__ __forceinline__ void p0_transpose_item(const float* W, int K, int N, bf16* WT, LAS float* scr, int item, int lane) {
    const int nblk = N / 32, kb = item / nblk, nb = item % nblk, k0 = 64 * kb, n0 = 32 * nb;
#pragma unroll 8
    for (int i = 0; i < 32; ++i) { const int kk = 2 * i + (lane >> 5); scr[kk * 33 + (lane & 31)] = W[(size_t)(k0 + kk) * N + n0 + (lane & 31)]; }
    LDS_WAIT(); asm volatile("" ::: "memory");
    const int c = lane & 7;
#pragma unroll
    for (int j = 0; j < 4; ++j) { const int n = (lane >> 3) + 8 * j; const LAS float* s = scr + (8 * c) * 33 + n;
        v4u o; o.x = pk2(s[0 * 33], s[1 * 33]); o.y = pk2(s[2 * 33], s[3 * 33]); o.z = pk2(s[4 * 33], s[5 * 33]); o.w = pk2(s[6 * 33], s[7 * 33]);
        *(GAS v4u*)(WT + (size_t)(n0 + n) * K + k0 + 8 * c) = o; }
    LDS_WAIT(); asm volatile("" ::: "memory");
}
__device__ __forceinline__ void p0_prologue(Frame& F) {
    LAS float* scr = (LAS float*)(F.lds + RING_OFF + F.wave * 16384);
    const int gw = F.vcu * NWAVES + F.wave, NGW = F.G * NWAVES;
    constexpr int I_IN = (D / 64) * (DAB / 32), I_OAB = (D / 64) * (D / 32), I_UP = (D / 64) * (FF / 32), I_DN = (FF / 64) * (D / 32), I_GRP = 2 * 4;
    constexpr int NITEMS = 2 * I_IN + 2 * I_OAB + 2 * I_UP + 2 * I_DN + 4 * I_GRP;
    for (int it = gw; it < NITEMS; it += NGW) {
        int r = it;
        if (r < I_IN) { p0_transpose_item(F.w_in, D, DAB, F.Win_t, scr, r, F.lane); continue; } r -= I_IN;
        if (r < I_IN) { p0_transpose_item(F.w_uv, D, DAB, F.Wuv_t, scr, r, F.lane); continue; } r -= I_IN;
        if (r < I_OAB) { p0_transpose_item(F.w_oab, D, D, F.Woab_t, scr, r, F.lane); continue; } r -= I_OAB;
        if (r < I_OAB) { p0_transpose_item(F.w_oc, D, D, F.Woc_t, scr, r, F.lane); continue; } r -= I_OAB;
        if (r < 2 * I_UP) { const int l = r / I_UP; p0_transpose_item(F.w_up + (size_t)l * D * FF, D, FF, F.Wup_t + (size_t)l * D * FF, scr, r % I_UP, F.lane); continue; } r -= 2 * I_UP;
        if (r < 2 * I_DN) { const int l = r / I_DN; p0_transpose_item(F.w_dn + (size_t)l * D * FF, FF, D, F.Wdn_t + (size_t)l * D * FF, scr, r % I_DN, F.lane); continue; } r -= 2 * I_DN;
        { const int g = r / I_GRP; p0_transpose_item(F.w_grp + (size_t)g * 128 * 128, 128, 128, F.Wg_t + (size_t)g * 128 * 128, scr, r % I_GRP, F.lane); }
    }
    for (int e = F.vcu * (NWAVES * 64) + F.tid; e < 8 * 128 * 128; e += F.G * NWAVES * 64) { const int t = (e >> 7) & 127, s = e & 127; F.Wsp[e] = (bf16)f2bf(s <= t ? F.w_sp[e] : 0.f); }
    f32x4 G1[4]; ld_row_f32(F.g_mix_pre, F.lane, G1);
    for (int r = gw; r < M; r += NGW) {
        f32x4 v[4]; ld_row_f32(x_row(F, nat_row(r)), F.lane, v);
        const float rs = rsqrtf(wave_sum(sumsq4(v)) * (1.f / D) + EPS);
#pragma unroll
        for (int j = 0; j < 4; ++j) v[j] = v[j] * rs * G1[j];
        st_row_bf16(F.XN + (size_t)r * D, F.lane, v);
    }
}

__device__ __forceinline__ void norm_phase(Frame& F, const bf16* MFb, const float* g1, const float* g2, bool first, bool last) {
    const int gw = F.vcu * NWAVES + F.wave, NGW = F.G * NWAVES;
    f32x4 G1[4], G2[4]; ld_row_f32(g1, F.lane, G1); ld_row_f32(g2, F.lane, G2);
    for (int r = gw; r < M; r += NGW) {
        const int n = nat_row(r);
        const float* base = first ? x_row(F, n) : (const float*)(F.out + (size_t)n * D);
        f32x4 m[4], x[4]; ld_row_bf16(MFb + (size_t)r * D, F.lane, m); ld_row_f32(base, F.lane, x);
        const float r1 = rsqrtf(wave_sum(sumsq4(m)) * (1.f / D) + EPS);
#pragma unroll
        for (int j = 0; j < 4; ++j) x[j] = x[j] + (m[j] * r1) * G1[j];
        st_row_f32(F.out + (size_t)n * D, F.lane, x);
        if (!last) {
            const float r2 = rsqrtf(wave_sum(sumsq4(x)) * (1.f / D) + EPS);
#pragma unroll
            for (int j = 0; j < 4; ++j) m[j] = (x[j] * r2) * G2[j];
            st_row_bf16(F.XN + (size_t)r * D, F.lane, m);
        }
    }
}

__device__ __forceinline__ void pool_unit(Frame& F, int pm, int g) {
    LAS unsigned char* U = F.lds; LAS unsigned char* Dt = F.lds + 36864; LAS unsigned char* Wl = F.lds + 69632;
    const int b = pm >> 3, t0 = (pm & 7) * 256, w = 2 << g;
    const int tid = F.tid, fr = F.lane & 15, fq = F.lane >> 4;
    { const GAS v4u* src = (const GAS v4u*)(F.Wg_t + (size_t)g * 128 * 128);
      for (int e = tid; e < 2048; e += NWAVES * 64) { const int n = e >> 4, sl = e & 15; *(LAS v4u*)(Wl + n * 256 + ((sl ^ (n & 15)) << 4)) = src[e]; } }
    for (int h = 0; h < 2; ++h) {
        const int th = t0 + 128 * h;
        for (int e = tid; e < 143 * 16; e += NWAVES * 64) { const int i = e >> 4, pc = e & 15, t = th - 15 + i; v4u v = (v4u){0u, 0u, 0u, 0u};
            if (t >= 0) v = *(const GAS v4u*)(F.P + (size_t)irow_p(b, t) * DAB + g * 128 + pc * 8);
            *(LAS v4u*)(U + i * 256 + pc * 16) = v; }
        __syncthreads();
        { const int c = tid & 127, q = tid >> 7; const LAS unsigned short* Uc = (const LAS unsigned short*)U + c;
          const int i0 = 15 + 32 * q; float s = 0.f;
          for (int k = 1; k < w; ++k) s += bf2f(Uc[(i0 - k) * 128]);
          const int slot = c >> 3, sub = (c & 7) * 2;
          for (int jj = 0; jj < 32; ++jj) { const int i = i0 + jj, rl = 32 * q + jj, t = th + rl;
              const float ut = bf2f(Uc[i * 128]); s += ut;
              const float cnt = (float)(t + 1 < w ? t + 1 : w); const float d = s / cnt - ut;
              *(LAS unsigned short*)(Dt + rl * 256 + ((slot ^ (rl & 15)) << 4) + sub) = (unsigned short)f2bf(d);
              s -= bf2f(Uc[(i - w + 1) * 128]); } }
        if ((pm & 7) == 7 && h == 1) {
            for (int e = tid; e < 15 * 128; e += NWAVES * 64) { const int k = e >> 7, c = e & 127; F.out[O_POOLP + ((size_t)b * 15 + k) * 512 + g * 128 + c] = bf2f(((const LAS unsigned short*)U)[(128 + k) * 128 + c]); } }
        __syncthreads();
        f32x4 acc[8];
#pragma unroll
        for (int nb = 0; nb < 8; ++nb) acc[nb] = (f32x4){0.f, 0.f, 0.f, 0.f};
        const int rl = 16 * F.wave + fr;
#pragma unroll
        for (int kk = 0; kk < 4; ++kk) { const int sl = kk * 4 + fq;
            const bf16x8 a = *(const LAS bf16x8*)(Dt + rl * 256 + ((sl ^ (rl & 15)) << 4));
#pragma unroll
            for (int nb = 0; nb < 8; ++nb) { const int n = nb * 16 + fr; const bf16x8 bw = *(const LAS bf16x8*)(Wl + n * 256 + ((sl ^ (n & 15)) << 4));
                acc[nb] = __builtin_amdgcn_mfma_f32_16x16x32_bf16(bw, a, acc[nb], 0, 0, 0); } }
        { const int ir = irow_p(b, th + rl); bf16* op = F.A3 + (size_t)ir * D + g * 128 + 4 * fq; const float* sc = F.pool_scale + g * 128 + 4 * fq;
#pragma unroll
          for (int nb = 0; nb < 8; ++nb) { const f32x4 s4 = *(const GAS f32x4*)(sc + nb * 16); const f32x4 v = acc[nb] * s4; *(GAS v2u*)(op + nb * 16) = (v2u){pk2(v[0], v[1]), pk2(v[2], v[3])}; } }
        __syncthreads();
    }
}
__device__ __forceinline__ void conv_unit(Frame& F, int pm, int q) {
    const int b = pm >> 3, t0 = (pm & 7) * 256, oct = F.tid & 15, seg = F.tid >> 4, c = 128 * q + 8 * oct, ts = t0 + 8 * seg;
    float w0[8], w1[8], w2[8], zm2[8], zm1[8];
    { const GAS f32x4* p = (const GAS f32x4*)(F.conv_w + c); const f32x4 a0 = p[0], a1 = p[1], b0 = p[128], b1 = p[129], c0 = p[256], c1 = p[257];
#pragma unroll
      for (int i = 0; i < 4; ++i) { w0[i] = a0[i]; w0[4 + i] = a1[i]; w1[i] = b0[i]; w1[4 + i] = b1[i]; w2[i] = c0[i]; w2[4 + i] = c1[i]; } }
#pragma unroll
    for (int i = 0; i < 8; ++i) { zm2[i] = 0.f; zm1[i] = 0.f; }
    if (ts >= 2) {
        const bf16* p2 = F.P + (size_t)irow_p(b, ts - 2) * DAB + c; const bf16* p1 = F.P + (size_t)irow_p(b, ts - 1) * DAB + c;
        float xb[8], gc[8];
        unpack8(*(const GAS v4u*)(p2 + 512), xb); unpack8(*(const GAS v4u*)(p2 + 1536), gc);
#pragma unroll
        for (int i = 0; i < 8; ++i) zm2[i] = gc[i] * xb[i];
        unpack8(*(const GAS v4u*)(p1 + 512), xb); unpack8(*(const GAS v4u*)(p1 + 1536), gc);
#pragma unroll
        for (int i = 0; i < 8; ++i) zm1[i] = gc[i] * xb[i];
    }
#pragma unroll 4
    for (int r = 0; r < 8; ++r) {
        const int tt = ts + r, ir = irow_p(b, tt); const bf16* pr = F.P + (size_t)ir * DAB + c;
        float xb[8], gb[8], gc[8], z[8], y[8];
        unpack8(*(const GAS v4u*)(pr + 512), xb); unpack8(*(const GAS v4u*)(pr + 1024), gb); unpack8(*(const GAS v4u*)(pr + 1536), gc);
#pragma unroll
        for (int i = 0; i < 8; ++i) { z[i] = gc[i] * xb[i]; y[i] = gb[i] * ((w0[i] * zm2[i] + w1[i] * zm1[i]) + w2[i] * z[i]); }
        *(GAS v4u*)(F.A3 + (size_t)ir * D + 512 + c) = (v4u){pk2(y[0], y[1]), pk2(y[2], y[3]), pk2(y[4], y[5]), pk2(y[6], y[7])};
        if (tt >= SEQ - 2) { GAS f32x4* o = (GAS f32x4*)(F.out + O_CONVP + ((size_t)b * 2 + (tt - (SEQ - 2))) * 512 + c); o[0] = (f32x4){z[0], z[1], z[2], z[3]}; o[1] = (f32x4){z[4], z[5], z[6], z[7]}; }
#pragma unroll
        for (int i = 0; i < 8; ++i) { zm2[i] = zm1[i]; zm1[i] = z[i]; }
    }
}
__device__ __forceinline__ void mix0_sample_unit(Frame& F, int sm) {
    LAS unsigned char* Ds = F.lds;
    const int c = F.tid, g = c >> 7, w = 2 << g, fr = F.lane & 15, fq = F.lane >> 4;
    const float cw0 = F.conv_w[c], cw1 = F.conv_w[512 + c], cw2 = F.conv_w[1024 + c];
    const float inv = 1.f / (float)w;
    for (int i = 0; i < 2; ++i) {
        const int b = 2 * sm + i;
        float full[23];
#pragma unroll
        for (int k = 0; k < 15; ++k) full[k] = F.spool[((size_t)b * 15 + k) * 512 + c];
#pragma unroll
        for (int t = 0; t < 8; ++t) full[15 + t] = bf2f(F.P[(size_t)irow_s(b, t) * DAB + c]);
#pragma unroll
        for (int t = 0; t < 8; ++t) { float s = 0.f;
#pragma unroll
            for (int k = 15; k >= 0; --k) if (k < w) s += full[15 + t - k];
            const float d = s * inv - full[15 + t]; const int row = i * 8 + t;
            *(LAS unsigned short*)(Ds + row * 1024 + (((c >> 3) ^ row) << 4) + (c & 7) * 2) = (unsigned short)f2bf(d); }
#pragma unroll
        for (int k = 0; k < 15; ++k) F.out[O_POOLS + ((size_t)b * 15 + k) * 512 + c] = full[8 + k];
        float zm2 = F.sconv[((size_t)b * 2 + 0) * 512 + c], zm1 = F.sconv[((size_t)b * 2 + 1) * 512 + c];
#pragma unroll
        for (int t = 0; t < 8; ++t) { const int ir = irow_s(b, t); const bf16* pr = F.P + (size_t)ir * DAB + c;
            const float xb = bf2f(pr[512]), gb = bf2f(pr[1024]), gc = bf2f(pr[1536]); const float z = gc * xb;
            F.A3[(size_t)ir * D + 512 + c] = (bf16)f2bf(gb * ((cw0 * zm2 + cw1 * zm1) + cw2 * z));
            if (t >= 6) F.out[O_CONVS + ((size_t)b * 2 + (t - 6)) * 512 + c] = z;
            zm2 = zm1; zm1 = z; }
    }
    __syncthreads();
    { const int g2 = F.wave >> 1, nb0 = (F.wave & 1) * 4;
      f32x4 acc[4];
#pragma unroll
      for (int j = 0; j < 4; ++j) acc[j] = (f32x4){0.f, 0.f, 0.f, 0.f};
#pragma unroll
      for (int kk = 0; kk < 4; ++kk) { const int sl = g2 * 16 + kk * 4 + fq; const bf16x8 a = *(const LAS bf16x8*)(Ds + fr * 1024 + ((sl ^ fr) << 4));
#pragma unroll
          for (int j = 0; j < 4; ++j) { const int n = (nb0 + j) * 16 + fr; const bf16x8 bw = *(const GAS bf16x8*)(F.Wg_t + ((size_t)g2 * 128 + n) * 128 + kk * 32 + fq * 8);
              acc[j] = __builtin_amdgcn_mfma_f32_16x16x32_bf16(bw, a, acc[j], 0, 0, 0); } }
      const int ir = irow_s(2 * sm + (fr >> 3), fr & 7);
#pragma unroll
      for (int j = 0; j < 4; ++j) { const int col = g2 * 128 + (nb0 + j) * 16 + 4 * fq; const f32x4 s4 = *(const GAS f32x4*)(F.pool_scale + col); const f32x4 v = acc[j] * s4;
          *(GAS v2u*)(F.A3 + (size_t)ir * D + col) = (v2u){pk2(v[0], v[1]), pk2(v[2], v[3])}; } }
    __syncthreads();
}
__device__ __forceinline__ void mixer0_phase(Frame& F) {
    for (int u = F.vcu; u < 256; u += F.G) pool_unit(F, u >> 2, u & 3);
    for (int u = F.vcu; u < 256; u += F.G) conv_unit(F, u >> 2, u & 3);
    for (int u = F.vcu; u < 64; u += F.G) mix0_sample_unit(F, u);
}

__device__ __forceinline__ void sp_unit(Frame& F, int ck, int hh) {
    LAS float* R = (LAS float*)F.lds; LAS unsigned char* VT = F.lds + 1024;
    const int b = ck >> 4, t0 = (ck & 15) * 128, tid = F.tid, lane = F.lane, wave = F.wave, fr = lane & 15, fq = lane >> 4;
    for (int i = 0; i < 16; ++i) { const int s = 16 * wave + i; f32x4 v[4]; ld_row_bf16(F.P + (size_t)irow_p(b, t0 + s) * DAB + 1024, lane, v);
        const float ss = wave_sum(sumsq4(v)); if (lane == 0) R[s] = rsqrtf(ss * (1.f / 1024.f) + EPS); }
    __syncthreads();
    for (int hi = 0; hi < 4; ++hi) {
        const int h = 4 * hh + hi;
        for (int e = tid; e < 2048; e += NWAVES * 64) { const int s = e >> 4, d0 = (e & 15) * 8;
            float v[8]; unpack8(*(const GAS v4u*)(F.P + (size_t)irow_p(b, t0 + s) * DAB + 1024 + h * 128 + d0), v);
            const GAS f32x4* gp = (const GAS f32x4*)(F.g_v + h * 128 + d0); const f32x4 ga = gp[0], gb = gp[1]; const float rs = R[s];
            const float gv[8] = {ga[0], ga[1], ga[2], ga[3], gb[0], gb[1], gb[2], gb[3]};
#pragma unroll
            for (int i = 0; i < 8; ++i) { const int d = d0 + i; *(LAS unsigned short*)(VT + d * 256 + (((s >> 3) ^ (d & 15)) << 4) + (s & 7) * 2) = (unsigned short)f2bf((v[i] * rs) * gv[i]); } }
        __syncthreads();
        f32x4 acc[8];
#pragma unroll
        for (int nb = 0; nb < 8; ++nb) acc[nb] = (f32x4){0.f, 0.f, 0.f, 0.f};
        const int nkk = (wave >> 1) + 1;
        for (int kk = 0; kk < nkk; ++kk) { const bf16x8 wf = *(const GAS bf16x8*)(F.Wsp + ((size_t)h * 128 + 16 * wave + fr) * 128 + kk * 32 + fq * 8); const int sl = kk * 4 + fq;
#pragma unroll
            for (int nb = 0; nb < 8; ++nb) { const int d = nb * 16 + fr; const bf16x8 vf = *(const LAS bf16x8*)(VT + d * 256 + ((sl ^ (d & 15)) << 4));
                acc[nb] = __builtin_amdgcn_mfma_f32_16x16x32_bf16(vf, wf, acc[nb], 0, 0, 0); } }
        { const int t = 16 * wave + fr, ir = irow_p(b, t0 + t); const float bias = F.b_sp[h * 128 + t];
          const bf16* up = F.P + (size_t)ir * DAB + h * 128 + 4 * fq; bf16* op = F.A3 + (size_t)ir * D + h * 128 + 4 * fq;
#pragma unroll
          for (int nb = 0; nb < 8; ++nb) { const v2u uu = *(const GAS v2u*)(up + nb * 16); const f32x4 a = acc[nb];
              *(GAS v2u*)(op + nb * 16) = (v2u){pk2(bflo(uu.x) * (a[0] + bias), bfhi(uu.x) * (a[1] + bias)), pk2(bflo(uu.y) * (a[2] + bias), bfhi(uu.y) * (a[3] + bias))}; } }
        __syncthreads();
    }
}
__device__ __forceinline__ void sp_sample_unit(Frame& F, int sm) {
    LAS float* VN = (LAS float*)F.lds;
    const int tid = F.tid, lane = F.lane, wave = F.wave;
    f32x4 GV[4]; ld_row_f32(F.g_v, lane, GV);
    for (int i = 0; i < 2; ++i) { const int row = 2 * wave + i, b = 2 * sm + (row >> 3), t = row & 7;
        f32x4 v[4]; ld_row_bf16(F.P + (size_t)irow_s(b, t) * DAB + 1024, lane, v);
        const float rs = rsqrtf(wave_sum(sumsq4(v)) * (1.f / 1024.f) + EPS);
#pragma unroll
        for (int j = 0; j < 4; ++j) v[j] = (v[j] * rs) * GV[j];
        st_row_f32(F.out + O_V + ((size_t)b * 8 + t) * 1024, lane, v);
        LAS f32x4* p = (LAS f32x4*)(VN + row * 1024) + 2 * lane; p[0] = v[0]; p[1] = v[1]; p[128] = v[2]; p[129] = v[3]; }
    __syncthreads();
    for (int cc = 0; cc < 2; ++cc) { const int c = tid + 512 * cc, h = c >> 7;
        for (int i = 0; i < 2; ++i) { const int b = 2 * sm + i; float vn[8];
#pragma unroll
            for (int s = 0; s < 8; ++s) vn[s] = VN[(i * 8 + s) * 1024 + c];
#pragma unroll
            for (int t = 0; t < 8; ++t) { float o = F.b_sp[h * 128 + t];
#pragma unroll
                for (int s = 0; s <= t; ++s) o += F.w_sp[((size_t)h * 128 + t) * 128 + s] * vn[s];
                const int ir = irow_s(b, t); F.A3[(size_t)ir * D + c] = (bf16)f2bf(bf2f(F.P[(size_t)ir * DAB + c]) * o); } } }
    __syncthreads();
}
__device__ __forceinline__ void mixer1_phase(Frame& F) {
    for (int u = F.vcu; u < 256; u += F.G) sp_unit(F, u >> 1, u & 1);
    for (int u = F.vcu; u < 64; u += F.G) sp_sample_unit(F, u);
}

struct Args { const float* in[20]; float* out; unsigned char* ws; };
__global__ void __launch_bounds__(NWAVES * 64, 2) fwd_megakernel(Args args) {
    extern __shared__ __attribute__((aligned(16))) unsigned char lds[];
    Frame F;
    F.lds = (LAS unsigned char*)lds;
    F.MISC = (volatile LAS unsigned*)(F.lds + MISC_OFF);
    F.tid = threadIdx.x; F.lane = F.tid & 63; F.wave = __builtin_amdgcn_readfirstlane(F.tid >> 6);
    F.G = gridDim.x; { const int bx = blockIdx.x; F.vcu = (F.G % 8 == 0) ? (bx % 8) * (F.G / 8) + bx / 8 : bx; }
    unsigned char* ws = args.ws;
    F.ctl = (gu32*)(ws + WS_CTL);
    F.xp = args.in[0]; F.xs = args.in[1]; F.spool = args.in[2]; F.sconv = args.in[3]; F.g_mix_pre = args.in[4]; F.g_mix_post = args.in[5]; F.g_ffn_pre = args.in[6]; F.g_ffn_post = args.in[7];
    F.w_in = args.in[8]; F.w_grp = args.in[9]; F.pool_scale = args.in[10]; F.conv_w = args.in[11]; F.w_oab = args.in[12]; F.w_uv = args.in[13]; F.g_v = args.in[14]; F.w_sp = args.in[15]; F.b_sp = args.in[16];
    F.w_oc = args.in[17]; F.w_up = args.in[18]; F.w_dn = args.in[19]; F.out = args.out;
    F.Win_t = (bf16*)(ws + WS_WIN); F.Woab_t = (bf16*)(ws + WS_WOAB); F.Wuv_t = (bf16*)(ws + WS_WUV); F.Woc_t = (bf16*)(ws + WS_WOC); F.Wup_t = (bf16*)(ws + WS_WUP); F.Wdn_t = (bf16*)(ws + WS_WDN);
    F.Wg_t = (bf16*)(ws + WS_WGRP); F.Wsp = (bf16*)(ws + WS_WSP);
    F.XN = (bf16*)(ws + WS_XN); F.P = (bf16*)(ws + WS_P); F.A3 = (bf16*)(ws + WS_A3); F.MF = (bf16*)(ws + WS_MF); F.MF2 = (bf16*)(ws + WS_MF2); F.H = (bf16*)(ws + WS_H);
    for (int u = F.tid; u < (LDS_BYTES - LDSCTL_OFF) / 4; u += NWAVES * 64) ((LAS unsigned*)(F.lds + LDSCTL_OFF))[u] = 0u;
    __syncthreads();
    XcdBarrier bar = xcd_barrier_post((unsigned*)(F.ctl + CW_BAR), F.MISC + 8);
#define GRID_BAR() xcd_barrier(bar)

    p0_prologue(F); GRID_BAR();
    for (int st = 0; st < 14; ++st) {
        const int l = st / 7, s = st % 7;
        { int tv = threadIdx.x; asm volatile("" : "+v"(tv)); F.tid = tv; F.lane = tv & 63; F.wave = __builtin_amdgcn_readfirstlane(tv >> 6); }
        if (s == 0 || s == 2 || s == 4 || s == 5) {
            const bf16* A; const bf16* Bt; bf16* O; int N, K, act = 0;
            if (s == 0) { A = F.XN; Bt = l ? F.Wuv_t : F.Win_t; N = DAB; K = D; O = F.P; }
            else if (s == 2) { A = F.A3; Bt = l ? F.Woc_t : F.Woab_t; N = D; K = D; O = F.MF; }
            else if (s == 4) { A = F.XN; Bt = F.Wup_t + (size_t)l * D * FF; N = FF; K = D; O = F.H; act = 1; }
            else { A = F.H; Bt = F.Wdn_t + (size_t)l * D * FF; N = D; K = FF; O = F.MF2; }
            pg8::Gemm g{A, Bt, 64, N, K}; pg8::StaticOrder S; S.init(64, N, F.G, (int)blockIdx.x);
            pg8::EpiBf16 E{O, N, act};
            pg8::gemm_phase<pg8::EpiBf16, pg8::StaticOrder, PG8_ALIGN>(F.lds + RING_OFF, g, S, E, F.tid);
        } else if (s == 1) {
            if (l == 0) mixer0_phase(F); else mixer1_phase(F);
        } else {
            const bool first = (st == 3), last = (st == 13);
            norm_phase(F, s == 3 ? F.MF : F.MF2, (s == 3 ? F.g_mix_post : F.g_ffn_post) + l * D, s == 3 ? F.g_ffn_pre + l * D : F.g_mix_pre + D, first, last);
        }
        if (st != 13) GRID_BAR();
    }
}

extern "C" void kernel_launch(void* const* d_in, const int* in_sizes, int n_in, void* d_out, int out_size, void* d_ws, size_t ws_size, hipStream_t stream) {
    static int grid = 0;
    if (grid == 0) {
        if (n_in != 20 || in_sizes[0] != MP * D || (size_t)out_size != O_END || ws_size < WS_END) { fprintf(stderr, "kernel_launch: unexpected shapes (n_in %d, in0 %d, out %d, ws %zu); nothing launched\n", n_in, n_in > 0 ? in_sizes[0] : -1, out_size, ws_size); grid = -1; return; }
        int dev = 0, cus = 0, per_cu = 0;
        if (hipGetDevice(&dev) != hipSuccess || hipDeviceGetAttribute(&cus, hipDeviceAttributeMultiprocessorCount, dev) != hipSuccess) { fprintf(stderr, "kernel_launch: hipGetDevice / hipDeviceGetAttribute failed\n"); grid = -1; return; }
        if (hipFuncSetAttribute((const void*)fwd_megakernel, hipFuncAttributeMaxDynamicSharedMemorySize, LDS_BYTES) != hipSuccess) { fprintf(stderr, "kernel_launch: hipFuncSetAttribute failed\n"); grid = -1; return; }
        if (hipOccupancyMaxActiveBlocksPerMultiprocessor(&per_cu, (const void*)fwd_megakernel, NWAVES * 64, LDS_BYTES) != hipSuccess || per_cu < 1)
            fprintf(stderr, "kernel_launch: note: occupancy query reports %d workgroups per CU\n", per_cu);
        (void)hipGetLastError();
        grid = cus;
    }
    if (grid < 0) return;
    if (hipMemsetAsync((char*)d_ws + WS_CTL, 0, CTL_ZERO_BYTES, stream) != hipSuccess) { fprintf(stderr, "kernel_launch: hipMemsetAsync failed\n"); return; }
    Args a{};
    for (int i = 0; i < 20; ++i) a.in[i] = (const float*)d_in[i];
    a.out = (float*)d_out; a.ws = (unsigned char*)d_ws;
    hipLaunchKernelGGL(fwd_megakernel, dim3(grid), dim3(NWAVES * 64), LDS_BYTES, stream, a);
    const hipError_t le = hipPeekAtLastError();
    if (le != hipSuccess) fprintf(stderr, "kernel_launch: launch failed: %s\n", hipGetErrorName(le));
}
```
